# Optimizing an MI355X kernel written in HIP

```python
import jax, jax.numpy as jnp
from jax import lax
import numpy as np

D_MODEL = 1024
BATCH = 8
SEQ = 2048
DEPTH = 2

ATTN_W = D_MODEL // 2
N_ATTN_HEADS = 8
HEAD_DIM = ATTN_W // N_ATTN_HEADS
POOL_W = D_MODEL - ATTN_W
POOL_WINDOWS = (2, 4, 8, 16)
POOL_C = POOL_W // len(POOL_WINDOWS)
IN_COLS = 3 * ATTN_W + N_ATTN_HEADS + POOL_W
D_FF = 2816
CONV_W = 3
Q_BLOCK = 128
EPS = 1e-6

kernel_name = "hybrid_fox_pool_convffn_adaln"


def _rmsnorm(x, g):
    x32 = x.astype(jnp.float32)
    y = x32 * lax.rsqrt(jnp.mean(x32 * x32, axis=-1, keepdims=True) + EPS)
    return (y * g.astype(jnp.float32)).astype(x.dtype)


def _fox_attention(q, k, v, log_f):
    B, S, H, Dh = q.shape
    nb = S // Q_BLOCK
    F = jnp.cumsum(log_f, axis=1)
    Fk = F.transpose(0, 2, 1)
    q32 = q.astype(jnp.float32) * (Dh ** -0.5)
    k32 = k.astype(jnp.float32)
    v32 = v.astype(jnp.float32)
    qb = q32.reshape(B, nb, Q_BLOCK, H, Dh).transpose(1, 0, 2, 3, 4)
    Fq = F.reshape(B, nb, Q_BLOCK, H).transpose(1, 0, 3, 2)
    kpos = jnp.arange(S)

    def one_block(args):
        i, qi, Fi = args
        s = jnp.einsum('bqhd,bkhd->bhqk', qi, k32)
        s = s + Fi[..., None] - Fk[:, :, None, :]
        qpos = i * Q_BLOCK + jnp.arange(Q_BLOCK)
        s = jnp.where(qpos[:, None] >= kpos[None, :], s, -jnp.inf)
        p = jax.nn.softmax(s, axis=-1)
        return jnp.einsum('bhqk,bkhd->bqhd', p, v32)

    o = lax.map(one_block, (jnp.arange(nb), qb, Fq))
    return o.transpose(1, 0, 2, 3, 4).reshape(B, S, H * Dh)


def _multiscale_pool(u, pool_w, pool_scale):
    B, S, _ = u.shape
    u32 = u.astype(jnp.float32)
    count = jnp.arange(1, S + 1, dtype=jnp.float32)
    outs = []
    for g, w in enumerate(POOL_WINDOWS):
        ug = u32[..., g * POOL_C:(g + 1) * POOL_C]
        csp = jnp.concatenate([jnp.zeros((B, 1, POOL_C), jnp.float32),
                               jnp.cumsum(ug, axis=1)], axis=1)
        lo = jnp.concatenate([jnp.zeros((B, w - 1, POOL_C), jnp.float32),
                              csp[:, :S - w + 1]], axis=1)
        mean = (csp[:, 1:] - lo) / jnp.minimum(count, w)[None, :, None]
        outs.append(jnp.einsum('bsc,cd->bsd', mean - ug, pool_w[g].astype(jnp.float32)))
    out = jnp.concatenate(outs, axis=-1) * pool_scale.astype(jnp.float32)
    return out.astype(u.dtype)


def _conv_ffn(h, w_up, conv_w, conv_b, w_down):
    S = h.shape[1]
    a = h @ w_up
    ap = jnp.pad(a, ((0, 0), (CONV_W - 1, 0), (0, 0)))
    conv = conv_b + ap[:, 0:S] * conv_w[0]
    for j in range(1, CONV_W):
        conv = conv + ap[:, j:j + S] * conv_w[j]
    gate, val = jnp.split(conv, 2, axis=-1)
    return (jax.nn.silu(gate) * val) @ w_down


def setup_inputs(seed: int = 0) -> dict:
    key = jax.random.key(seed)
    ks = jax.random.split(key, 18)
    f32 = jnp.float32
    nrm = lambda k, shape, s: jax.random.normal(k, shape, f32) * s
    return {
        "x": nrm(ks[0], (BATCH, SEQ, D_MODEL), 1.0),
        "c": nrm(ks[1], (BATCH, D_MODEL), 1.0),
        "mod_w": nrm(ks[2], (DEPTH, D_MODEL, 6 * D_MODEL), 0.5 * D_MODEL ** -0.5),
        "mod_b": nrm(ks[3], (DEPTH, 6 * D_MODEL), 0.02),
        "norm1_g": 1.0 + nrm(ks[4], (DEPTH, D_MODEL), 0.02),
        "norm2_g": 1.0 + nrm(ks[5], (DEPTH, D_MODEL), 0.02),
        "w_in": nrm(ks[6], (DEPTH, D_MODEL, IN_COLS), D_MODEL ** -0.5),
        "b_f": jax.random.uniform(ks[7], (DEPTH, N_ATTN_HEADS), f32, 1.0, 6.0),
        "pool_w": nrm(ks[8], (DEPTH, len(POOL_WINDOWS), POOL_C, POOL_C), POOL_C ** -0.5),
        "pool_scale": 1.0 + nrm(ks[9], (DEPTH, POOL_W), 0.1),
        "w_out": nrm(ks[10], (DEPTH, ATTN_W + POOL_W, D_MODEL), (ATTN_W + POOL_W) ** -0.5),
        "ffn_up": nrm(ks[11], (DEPTH, D_MODEL, 2 * D_FF), D_MODEL ** -0.5),
        "ffn_conv_w": nrm(ks[12], (DEPTH, CONV_W, 2 * D_FF), CONV_W ** -0.5),
        "ffn_conv_b": nrm(ks[13], (DEPTH, 2 * D_FF), 0.02),
        "ffn_down": nrm(ks[14], (DEPTH, D_FF, D_MODEL), D_FF ** -0.5),
        "final_g": 1.0 + nrm(ks[15], (D_MODEL,), 0.02),
    }


def reference(x, c, mod_w, mod_b, norm1_g, norm2_g, w_in, b_f, pool_w, pool_scale,
              w_out, ffn_up, ffn_conv_w, ffn_conv_b, ffn_down, final_g):
    B, S, _ = x.shape
    c_act = jax.nn.silu(c)
    splits = [ATTN_W, 2 * ATTN_W, 3 * ATTN_W, 3 * ATTN_W + N_ATTN_HEADS]
    for l in range(DEPTH):
        mod = (c_act @ mod_w[l] + mod_b[l])[:, None, :]
        sh1, sc1, g1, sh2, sc2, g2 = jnp.split(mod, 6, axis=-1)

        h = _rmsnorm(x, norm1_g[l]) * (1.0 + sc1) + sh1
        z = h @ w_in[l]
        q, k, v, f_logit, u = jnp.split(z, splits, axis=-1)
        log_f = jax.nn.log_sigmoid((f_logit + b_f[l]).astype(jnp.float32))
        hd = (B, S, N_ATTN_HEADS, HEAD_DIM)
        attn = _fox_attention(q.reshape(hd), k.reshape(hd), v.reshape(hd), log_f)
        pool = _multiscale_pool(u, pool_w[l], pool_scale[l])
        mixed = jnp.concatenate([attn.astype(x.dtype), pool], axis=-1)
        x = x + g1 * (mixed @ w_out[l])

        h = _rmsnorm(x, norm2_g[l]) * (1.0 + sc2) + sh2
        x = x + g2 * _conv_ffn(h, ffn_up[l], ffn_conv_w[l], ffn_conv_b[l], ffn_down[l])
    return _rmsnorm(x, final_g)
```

```cpp
#include <hip/hip_runtime.h>
#include <hip/hip_cooperative_groups.h>
#include <cstdio>
#include <cstdint>
namespace cg = cooperative_groups;
namespace pg8 {
#define PG8_LAS __attribute__((address_space(3)))
typedef unsigned short bf16_t;
typedef short bf16x8 __attribute__((ext_vector_type(8)));
typedef float f32x4 __attribute__((ext_vector_type(4)));
typedef unsigned u32x4 __attribute__((ext_vector_type(4)));
constexpr int BM = 256, BK = 64, HALF = 128, HTB = HALF * BK * 2  , STAGE_BYTES = 8 * HTB, NXCD = 8, WGM = 8;

__host__ __device__ __forceinline__ int lds_byte(int r, int c) { const int st = (r >> 4) * 2 + (c >> 5), rr = r & 15, cc = c & 31, ob = rr * 64 + cc * 2; return st * 1024 + (ob ^ (((ob >> 9) & 1) << 5)); }
__host__ __device__ __forceinline__ void stage_rc(int b, int& R, int& C) { const int st = b / 1024, sb = b % 1024, swz = sb ^ (((sb >> 9) & 1) << 5); R = (st >> 1) * 16 + swz / 64; C = (st & 1) * 32 + (swz % 64) / 2; }
__host__ __device__ __forceinline__ int perm32(int rho) { const int n = rho >> 4, i = rho & 15; return 8 * (i >> 2) + 4 * n + (i & 3); }

struct Unit { int pm, pn; };
struct Gemm { const bf16_t* A; const bf16_t* Bt; int M, N, K; };

struct StaticOrder {
    int nM, nN, nwg, G, c;
    __host__ __device__ void init(int M, int N, int G_, int c_) { nM = M / BM; nN = N / BM; nwg = nM * nN; G = G_; c = c_; }
    __host__ __device__ bool next(int i, Unit& u) const {
        const long L = (long)i * G + c; if (L >= nwg) return false;
        int wgid = (int)L; { const int q = nwg / NXCD, r = nwg % NXCD, xcd = wgid % NXCD, off = wgid / NXCD; wgid = (xcd < r ? xcd * (q + 1) : r * (q + 1) + (xcd - r) * q) + off; }
        const int nig = WGM * nN, gid = wgid / nig, fm = gid * WGM, gsz = (nM - fm) < WGM ? (nM - fm) : WGM;
        u.pm = fm + ((wgid % nig) % gsz); u.pn = (wgid % nig) / gsz; return true;
    }
    __device__ __forceinline__ void a_ready(const Unit&) const {}
    __device__ __forceinline__ void done(const Unit&) const {}
};

__device__ __forceinline__ unsigned cvt_pk_bf16(float lo, float hi) { unsigned r; asm volatile("v_cvt_pk_bf16_f32 %0, %1, %2" : "=v"(r) : "v"(lo), "v"(hi)); return r; }
typedef unsigned u32x2 __attribute__((ext_vector_type(2)));
struct EpiBf16 {
    static constexpr bool PERM = true, AFTER_DRAIN = false;
    bf16_t* O; int ldc; int split_cols; size_t split_stride; float scale0;
    __device__ __forceinline__ void operator()(const f32x4 (&acc)[2][2][4][2], const Unit& u, int wr, int wc, int fr, int fq) const {
        const int row0 = u.pm * BM + wr * 64 + fr; int colt = u.pn * BM; bf16_t* base = O;
        float sc = 1.f; { const int t = colt / split_cols; base += (size_t)t * split_stride; colt -= t * split_cols; if (t == 0) sc = scale0; }
        const int col0 = colt + wc * 32 + 8 * fq;
#pragma unroll
        for (int ai = 0; ai < 2; ++ai)
#pragma unroll
            for (int m = 0; m < 4; ++m) { bf16_t* rowp = base + (size_t)(row0 + ai * HALF + m * 16) * ldc + col0;
#pragma unroll
                for (int bj = 0; bj < 2; ++bj) { f32x4 v0 = acc[ai][bj][m][0] * sc, v1 = acc[ai][bj][m][1] * sc;
                    u32x4 w; w.x = cvt_pk_bf16(v0[0], v0[1]); w.y = cvt_pk_bf16(v0[2], v0[3]); w.z = cvt_pk_bf16(v1[0], v1[1]); w.w = cvt_pk_bf16(v1[2], v1[3]);
                    *(u32x4*)(rowp + bj * HALF) = w; } }
    }
};
struct EpiRes {
    static constexpr bool PERM = false, AFTER_DRAIN = false;
    const float* base; float* out; const float* part; int l, which;
    __device__ __forceinline__ void operator()(const f32x4 (&acc)[2][2][4][2], const Unit& u, int wr, int wc, int fr, int fq) const {
        const int b = u.pm >> 3; const int col0 = u.pn * BM + wc * 32 + 4 * fq;
        f32x4 gv[2][2];
#pragma unroll
        for (int bj = 0; bj < 2; ++bj)
#pragma unroll
            for (int n = 0; n < 2; ++n) { f32x4 s = (f32x4){0.f, 0.f, 0.f, 0.f};
#pragma unroll
                for (int kc = 0; kc < 8; ++kc) s += *(const f32x4*)(part + ((size_t)((kc * 2 + l) * 8 + b)) * 6144 + which * 1024 + col0 + bj * HALF + n * 16);
                gv[bj][n] = s; }
#pragma unroll
        for (int ai = 0; ai < 2; ++ai)
#pragma unroll
            for (int m = 0; m < 4; ++m) { const size_t off = (size_t)(u.pm * BM + ai * HALF + wr * 64 + m * 16 + fr) * 1024 + col0;
#pragma unroll
                for (int bj = 0; bj < 2; ++bj)
#pragma unroll
                    for (int n = 0; n < 2; ++n) { const f32x4 bs = *(const f32x4*)(base + off + bj * HALF + n * 16);
                        *(f32x4*)(out + off + bj * HALF + n * 16) = bs + gv[bj][n] * acc[ai][bj][m][n]; }
                if (m & 1) asm volatile("" ::: "memory"); }
    }
};
__device__ __forceinline__ float dpp_ror1(float v) { return __builtin_bit_cast(float, __builtin_amdgcn_mov_dpp(__builtin_bit_cast(int, v), 0x121, 0xf, 0xf, true)); }
__device__ __forceinline__ float dpp_ror2(float v) { return __builtin_bit_cast(float, __builtin_amdgcn_mov_dpp(__builtin_bit_cast(int, v), 0x122, 0xf, 0xf, true)); }
struct EpiConv {
    static constexpr bool PERM = true, AFTER_DRAIN = false;
    bf16_t* Gout; float* raw; const float* cw; const float* cb;
    __device__ __forceinline__ void operator()(const f32x4 (&acc)[2][2][4][2], const Unit& u, int wr, int wc, int fr, int fq) const {
        const int ch0 = u.pn * 128 + wc * 32 + 8 * fq;
#pragma unroll
        for (int n = 0; n < 2; ++n) {
            const int ch = ch0 + 4 * n;
            f32x4 w0[2], w1[2], w2[2], bb[2];
#pragma unroll
            for (int bj = 0; bj < 2; ++bj) { const int c = bj * 2816 + ch;
                w0[bj] = *(const f32x4*)(cw + c); w1[bj] = *(const f32x4*)(cw + 5632 + c); w2[bj] = *(const f32x4*)(cw + 2 * 5632 + c); bb[bj] = *(const f32x4*)(cb + c); }
#pragma unroll
            for (int ai = 0; ai < 2; ++ai)
#pragma unroll
                for (int m = 0; m < 4; ++m) {
                    const int row = u.pm * BM + ai * HALF + wr * 64 + m * 16 + fr;
                    f32x4 cv[2];
#pragma unroll
                    for (int bj = 0; bj < 2; ++bj) {
                        const f32x4 cur = acc[ai][bj][m][n]; const f32x4 prv = acc[ai][bj][m > 0 ? m - 1 : 0][n];
                        f32x4 p1, p2;
#pragma unroll
                        for (int e = 0; e < 4; ++e) { const float c1 = dpp_ror1(cur[e]), c2 = dpp_ror2(cur[e]), q1 = dpp_ror1(prv[e]), q2 = dpp_ror2(prv[e]);
                            p1[e] = fr >= 1 ? c1 : q1; p2[e] = fr >= 2 ? c2 : q2; }
                        cv[bj] = bb[bj] + w0[bj] * p2 + w1[bj] * p1 + w2[bj] * cur;
                        if (m == 0 && fr < 2) *(f32x4*)(raw + ((size_t)(row >> 6) * 4 + fr) * 5632 + bj * 2816 + ch) = cur;
                        if (m == 3 && fr >= 14) *(f32x4*)(raw + ((size_t)(row >> 6) * 4 + (fr - 12)) * 5632 + bj * 2816 + ch) = cur;
                    }
                    if (!(m == 0 && fr < 2)) {
                        f32x4 g;
#pragma unroll
                        for (int e = 0; e < 4; ++e) { const float x = cv[0][e]; g[e] = x * __builtin_amdgcn_rcpf(1.f + __builtin_amdgcn_exp2f(-1.4426950408889634f * x)) * cv[1][e]; }
                        u32x2 w; w.x = cvt_pk_bf16(g[0], g[1]); w.y = cvt_pk_bf16(g[2], g[3]);
                        *(u32x2*)(Gout + (size_t)row * 2816 + ch) = w;
                    }
                }
        }
    }
};
template <class Epi, class Sched, bool ALIGN_EPI = false, bool SP2 = false>
__device__ __forceinline__ void gemm_phase(PG8_LAS unsigned char* lds, const Gemm g, const Sched& S, const Epi& E, const int tid) {
    const int wid = __builtin_amdgcn_readfirstlane(tid >> 6), lane = tid & 63, wr = wid >> 2, wc = wid & 3, fr = lane & 15, fq = lane >> 4;
    const int K = g.K, nt = K / BK;
    unsigned voffA[2], voffB[2];
#pragma unroll
    for (int i = 0; i < 2; ++i) { int R, C; stage_rc(tid * 16 + i * 8192, R, C); const int Rb = Epi::PERM ? ((R & ~31) + perm32(R & 31)) : R;
        voffA[i] = (unsigned)(R * K + C) * 2u; voffB[i] = (unsigned)(Rb * K + C) * 2u; }
    const size_t kstep = (size_t)(BK * 2);
    const size_t hstep = (size_t)HALF * K * 2;
    const size_t tstep = 2 * hstep;
    const unsigned ldsw = (unsigned)wid * 1024u;
    const int aoff = lds_byte(wr * 64 + fr, fq * 8), boff = lds_byte(wc * 32 + fr, fq * 8);
#define PG8_SA(b, h) (((b) * 2 + (h)) * HTB)
#define PG8_SB(b, h) ((4 + (b) * 2 + (h)) * HTB)
#define PG8_STAGE(bufoff, gbase, voff) do { _Pragma("unroll") for (int _i = 0; _i < 2; ++_i) \
        __builtin_amdgcn_global_load_lds((const unsigned*)((const char*)(gbase) + (voff)[_i]), (PG8_LAS unsigned*)(lds + (bufoff) + ldsw + _i * 8192), 16, 0, 0); } while (0)
#define PG8_LDA(dst, b, h) do { _Pragma("unroll") for (int m = 0; m < 4; ++m) _Pragma("unroll") for (int k = 0; k < 2; ++k) dst[m][k] = *(const PG8_LAS bf16x8*)(lds + PG8_SA(b, h) + aoff + m * 2048 + k * 1024); } while (0)
#define PG8_LDB(dst, b, h) do { _Pragma("unroll") for (int n = 0; n < 2; ++n) _Pragma("unroll") for (int k = 0; k < 2; ++k) dst[n][k] = *(const PG8_LAS bf16x8*)(lds + PG8_SB(b, h) + boff + n * 2048 + k * 1024); } while (0)
#define PG8_MMA(ai, bj, At, Bt) do { __builtin_amdgcn_s_setprio(1); _Pragma("unroll") for (int m = 0; m < 4; ++m) _Pragma("unroll") for (int n = 0; n < 2; ++n) _Pragma("unroll") for (int k = 0; k < 2; ++k) \
        acc[ai][bj][m][n] = __builtin_amdgcn_mfma_f32_16x16x32_bf16(Bt[n][k], At[m][k], acc[ai][bj][m][n], 0, 0, 0); __builtin_amdgcn_s_setprio(0); } while (0)
#define PG8_WAIT_V(n) asm volatile("s_waitcnt vmcnt(" #n ")" ::: "memory")
#define PG8_WAIT_L(n) asm volatile("s_waitcnt lgkmcnt(" #n ")" ::: "memory")
#define PG8_BAR __builtin_amdgcn_s_barrier()
#define PG8_SCHED __builtin_amdgcn_sched_barrier(0)
    Unit cur, nxt; int ui = 0;
    if (!S.next(0, cur)) return;
    f32x4 acc[2][2][4][2];
#pragma unroll
    for (int a = 0; a < 2; ++a)
#pragma unroll
        for (int b = 0; b < 2; ++b)
#pragma unroll
            for (int m = 0; m < 4; ++m)
#pragma unroll
                for (int n = 0; n < 2; ++n) acc[a][b][m][n] = (f32x4){0.f, 0.f, 0.f, 0.f};
    bf16x8 At[4][2], B0[2][2], B1[2][2];
    const char* cA = (const char*)g.A + (size_t)cur.pm * tstep; const char* cB = (const char*)g.Bt + (size_t)cur.pn * tstep;
    S.a_ready(cur);
    if constexpr (SP2) {
        PG8_STAGE(PG8_SB(0, 0), cB, voffB); PG8_STAGE(PG8_SB(0, 1), cB + hstep, voffB); PG8_STAGE(PG8_SA(0, 0), cA, voffA); PG8_STAGE(PG8_SA(0, 1), cA + hstep, voffA);
        if (wr == 1) PG8_BAR;
        PG8_WAIT_V(2); PG8_BAR;
        PG8_STAGE(PG8_SB(1, 0), cB + kstep, voffB); PG8_STAGE(PG8_SA(1, 0), cA + kstep, voffA); PG8_STAGE(PG8_SB(1, 1), cB + hstep + kstep, voffB);
        PG8_WAIT_V(6); PG8_BAR;
    } else {
        PG8_STAGE(PG8_SB(0, 0), cB, voffB); PG8_STAGE(PG8_SA(0, 0), cA, voffA); PG8_STAGE(PG8_SB(0, 1), cB + hstep, voffB); PG8_STAGE(PG8_SA(0, 1), cA + hstep, voffA);
        if (wr == 1) PG8_BAR;
        PG8_WAIT_V(4); PG8_BAR;
        PG8_STAGE(PG8_SB(1, 0), cB + kstep, voffB); PG8_STAGE(PG8_SA(1, 0), cA + kstep, voffA); PG8_STAGE(PG8_SB(1, 1), cB + hstep + kstep, voffB);
        PG8_WAIT_V(6); PG8_BAR;
    }
    for (;;) {
        const bool has_next = S.next(ui + 1, nxt);
        const char* nA = has_next ? (const char*)g.A + (size_t)nxt.pm * tstep : cA; const char* nB = has_next ? (const char*)g.Bt + (size_t)nxt.pn * tstep : cB;
        for (int t = 0; t < nt; t += 2) {
            const bool last = (t == nt - 2);
            const char* a1 = cA + (size_t)(t + 1) * kstep;
            const char* a2 = last ? nA : cA + (size_t)(t + 2) * kstep; const char* b2 = last ? nB : cB + (size_t)(t + 2) * kstep;
            const char* a3 = a2 + kstep; const char* b3 = b2 + kstep;
            if (last && has_next) S.a_ready(nxt);
            if constexpr (SP2) {
            PG8_LDB(B0, 0, 0); PG8_LDB(B1, 0, 1); PG8_SCHED; PG8_LDA(At, 0, 0); PG8_STAGE(PG8_SA(1, 1), a1 + hstep, voffA);
            PG8_WAIT_V(8); PG8_WAIT_L(0); PG8_BAR; PG8_MMA(0, 0, At, B0); PG8_MMA(0, 1, At, B1); PG8_BAR; PG8_SCHED;
            PG8_LDA(At, 0, 1); PG8_STAGE(PG8_SB(0, 0), b2, voffB); PG8_STAGE(PG8_SB(0, 1), b2 + hstep, voffB); PG8_STAGE(PG8_SA(0, 0), a2, voffA);
            PG8_WAIT_V(8); PG8_WAIT_L(0); PG8_BAR; PG8_MMA(1, 0, At, B0); PG8_MMA(1, 1, At, B1); PG8_BAR; PG8_SCHED;
            PG8_LDB(B0, 1, 0); PG8_LDB(B1, 1, 1); PG8_SCHED; PG8_LDA(At, 1, 0); PG8_STAGE(PG8_SA(0, 1), a2 + hstep, voffA);
            PG8_WAIT_V(8); PG8_WAIT_L(0); PG8_BAR; PG8_MMA(0, 0, At, B0); PG8_MMA(0, 1, At, B1); PG8_BAR; PG8_SCHED;
            PG8_LDA(At, 1, 1); PG8_STAGE(PG8_SB(1, 0), b3, voffB); PG8_STAGE(PG8_SB(1, 1), b3 + hstep, voffB); PG8_STAGE(PG8_SA(1, 0), a3, voffA);
            PG8_WAIT_V(8); PG8_WAIT_L(0); PG8_BAR; PG8_MMA(1, 0, At, B0); PG8_MMA(1, 1, At, B1); PG8_BAR; PG8_SCHED;
            } else {
            PG8_LDB(B0, 0, 0); PG8_SCHED; PG8_LDA(At, 0, 0); PG8_STAGE(PG8_SA(1, 1), a1 + hstep, voffA);
            PG8_WAIT_L(8); PG8_BAR; PG8_WAIT_L(0); PG8_MMA(0, 0, At, B0); PG8_BAR; PG8_SCHED;
            PG8_LDB(B1, 0, 1); PG8_STAGE(PG8_SB(0, 0), b2, voffB);
            PG8_BAR; PG8_WAIT_L(0); PG8_MMA(0, 1, At, B1); PG8_BAR;
            PG8_LDA(At, 0, 1); PG8_STAGE(PG8_SA(0, 0), a2, voffA);
            PG8_BAR; PG8_WAIT_L(0); PG8_MMA(1, 0, At, B0); PG8_BAR; PG8_SCHED;
            PG8_STAGE(PG8_SB(0, 1), b2 + hstep, voffB);
            PG8_WAIT_V(6); PG8_BAR; PG8_MMA(1, 1, At, B1); PG8_BAR;
            PG8_LDB(B0, 1, 0); PG8_SCHED; PG8_LDA(At, 1, 0); PG8_STAGE(PG8_SA(0, 1), a2 + hstep, voffA);
            PG8_WAIT_L(8); PG8_BAR; PG8_WAIT_L(0); PG8_MMA(0, 0, At, B0); PG8_BAR; PG8_SCHED;
            PG8_LDB(B1, 1, 1); PG8_STAGE(PG8_SB(1, 0), b3, voffB);
            PG8_BAR; PG8_WAIT_L(0); PG8_MMA(0, 1, At, B1); PG8_BAR;
            PG8_LDA(At, 1, 1); PG8_STAGE(PG8_SA(1, 0), a3, voffA);
            PG8_BAR; PG8_WAIT_L(0); PG8_MMA(1, 0, At, B0); PG8_BAR; PG8_SCHED;
            PG8_STAGE(PG8_SB(1, 1), b3 + hstep, voffB);
            PG8_WAIT_V(6); PG8_BAR; PG8_MMA(1, 1, At, B1); PG8_BAR;
            }
        }
        if constexpr (ALIGN_EPI) { if (wr == 0) PG8_BAR; }
        if constexpr (!Epi::AFTER_DRAIN) { E(acc, cur, wr, wc, fr, fq); S.done(cur); }
        if (!has_next) break;
#pragma unroll
        for (int a = 0; a < 2; ++a)
#pragma unroll
            for (int b = 0; b < 2; ++b)
#pragma unroll
                for (int m = 0; m < 4; ++m)
#pragma unroll
                    for (int n = 0; n < 2; ++n) acc[a][b][m][n] = (f32x4){0.f, 0.f, 0.f, 0.f};
        cur = nxt; cA = nA; cB = nB; ++ui;
        if constexpr (ALIGN_EPI) { if (wr == 1) PG8_BAR; }
    }
    PG8_WAIT_V(0);
    if constexpr (!ALIGN_EPI) { if (wr == 0) PG8_BAR; }
    PG8_BAR;
    if constexpr (Epi::AFTER_DRAIN) { E.fused(acc, cur, wr, wc, fr, fq, lds, wid, lane); S.done(cur); }
#undef PG8_SA
#undef PG8_SB
#undef PG8_STAGE
#undef PG8_LDA
#undef PG8_LDB
#undef PG8_MMA
#undef PG8_WAIT_V
#undef PG8_WAIT_L
#undef PG8_BAR
#undef PG8_SCHED
}
}
#define LAS __attribute__((address_space(3)))
typedef unsigned short bf16_t;
typedef short bf16x8 __attribute__((ext_vector_type(8)));
typedef short s16x4 __attribute__((ext_vector_type(4)));
typedef float f32x4 __attribute__((ext_vector_type(4)));
typedef float f32x16 __attribute__((ext_vector_type(16)));
typedef unsigned u32x4 __attribute__((ext_vector_type(4)));
typedef unsigned u32x2 __attribute__((ext_vector_type(2)));
constexpr int NB = 8, SEQ = 2048, DM = 1024, MR = NB * SEQ, NH = 8, HD = 64, AW = 512, INC = 2056, FF = 2816, FF2 = 5632, NL = 2;
constexpr float EPS = 1e-6f, LOG2E = 1.4426950408889634f, QSCALE = 0.125f * 1.4426950408889634f;
constexpr size_t MiB = 1u << 20;
constexpr size_t WS_PART = 1 * MiB;
constexpr size_t WS_LF = 4 * MiB;
constexpr size_t WS_W0 = 5 * MiB, WS_WL = 23 * MiB;
constexpr size_t WO_IN = 0, WO_OUT = 4 * MiB, WO_UP = 6 * MiB, WO_DN = 17 * MiB, WO_PW = 22 * MiB + 512 * 1024;
constexpr size_t WS_XN = 52 * MiB;
constexpr size_t WS_Q = 84 * MiB, WS_K = 100 * MiB, WS_V = 116 * MiB, WS_U = 132 * MiB, WS_MIX = 148 * MiB;
constexpr size_t WS_G = 84 * MiB;
constexpr size_t WS_RAW = 180 * MiB;
constexpr size_t WS_END = 202 * MiB;
constexpr int LDS_BYTES = 147456;

__device__ __forceinline__ unsigned pk_bf16(float lo, float hi) { unsigned r; asm volatile("v_cvt_pk_bf16_f32 %0, %1, %2" : "=v"(r) : "v"(lo), "v"(hi)); return r; }
__device__ __forceinline__ float bf_lo(unsigned w) { return __uint_as_float(w << 16); }
__device__ __forceinline__ float bf_hi(unsigned w) { return __uint_as_float(w & 0xffff0000u); }
__device__ __forceinline__ float wave_sum(float v) {
#pragma unroll
    for (int o = 1; o < 64; o <<= 1) v += __shfl_xor(v, o);
    return v;
}

struct Args { const float* x; const float* c; const float* mod_w; const float* mod_b; const float* n1g; const float* n2g; const float* w_in; const float* b_f;
              const float* pool_w; const float* pool_scale; const float* w_out; const float* ffn_up; const float* conv_w; const float* conv_b; const float* ffn_down;
              const float* final_g; float* out; unsigned char* ws; int ph_lo, ph_hi; };

__device__ __forceinline__ void transpose_item(const float* W, int ldn, int k0, int n0src, bf16_t* WT, int K, int dst0, LAS float* scr, int lane) {
#pragma unroll 8
    for (int i = 0; i < 32; ++i) { const int kk = 2 * i + (lane >> 5); scr[kk * 33 + (lane & 31)] = W[(size_t)(k0 + kk) * ldn + n0src + (lane & 31)]; }
    asm volatile("s_waitcnt lgkmcnt(0)" ::: "memory");
    const int c = lane & 7;
#pragma unroll
    for (int j = 0; j < 4; ++j) { const int n = (lane >> 3) + 8 * j; const LAS float* s = scr + (8 * c) * 33 + n;
        u32x4 o; o.x = pk_bf16(s[0 * 33], s[1 * 33]); o.y = pk_bf16(s[2 * 33], s[3 * 33]); o.z = pk_bf16(s[4 * 33], s[5 * 33]); o.w = pk_bf16(s[6 * 33], s[7 * 33]);
        *(u32x4*)(WT + (size_t)(dst0 + n) * K + k0 + 8 * c) = o; }
    asm volatile("s_waitcnt lgkmcnt(0)" ::: "memory");
}
__device__ __forceinline__ void prologue(const Args& a, LAS unsigned char* lds, int tid, int lane, int wave, int G) {
    LAS float* cact = (LAS float*)(lds + 73728);
    for (int i = tid; i < NB * DM; i += 512) { const int b = i >> 10, k = i & 1023; const float v = a.c[i]; cact[k * 8 + b] = v / (1.f + __expf(-v)); }
    __syncthreads();
    LAS float* scr = (LAS float*)(lds + wave * 8704);
    float* part = (float*)(a.ws + WS_PART);
    const int gw = wave * G + (int)blockIdx.x, NGW = G * 8;
    constexpr int I_MOD = NL * 24 * 8, I_IN = 16 * 64, I_OUT = 16 * 32, I_UP = 16 * 176, I_DN = 44 * 32, I_PW = 4 * 2 * 4, I_L = I_IN + I_OUT + I_UP + I_DN + I_PW;
    for (int it = gw; it < I_MOD + NL * I_L; it += NGW) {
        if (it < I_MOD) {
            const int l = it / 192, r = it % 192, cc = r >> 3, kc = r & 7;
            const float* Wm = a.mod_w + (size_t)l * DM * 6144 + (size_t)(kc * 128) * 6144 + cc * 256 + lane * 4;
            f32x4 acc[8];
#pragma unroll
            for (int b = 0; b < 8; ++b) acc[b] = (f32x4){0.f, 0.f, 0.f, 0.f};
#pragma unroll 8
            for (int kk = 0; kk < 128; ++kk) { const f32x4 w = *(const f32x4*)(Wm + (size_t)kk * 6144);
                const f32x4 c0 = *(const LAS f32x4*)(cact + (kc * 128 + kk) * 8), c1 = *(const LAS f32x4*)(cact + (kc * 128 + kk) * 8 + 4);
                acc[0] += w * c0[0]; acc[1] += w * c0[1]; acc[2] += w * c0[2]; acc[3] += w * c0[3]; acc[4] += w * c1[0]; acc[5] += w * c1[1]; acc[6] += w * c1[2]; acc[7] += w * c1[3]; }
            if (kc == 0) { const f32x4 bv = *(const f32x4*)(a.mod_b + l * 6144 + cc * 256 + lane * 4);
#pragma unroll
                for (int b = 0; b < 8; ++b) acc[b] += bv; }
#pragma unroll
            for (int b = 0; b < 8; ++b) *(f32x4*)(part + ((size_t)((kc * 2 + l) * 8 + b)) * 6144 + cc * 256 + lane * 4) = acc[b];
            continue;
        }
        int r = it - I_MOD; const int l = r / I_L; r -= l * I_L;
        unsigned char* wl = a.ws + WS_W0 + (size_t)l * WS_WL;
        if (r < I_IN) { const int kb = r / 64, nb = r % 64; const int src = nb < 48 ? 32 * nb : 1544 + 32 * (nb - 48);
            transpose_item(a.w_in + (size_t)l * DM * INC, INC, 64 * kb, src, (bf16_t*)(wl + WO_IN), DM, 32 * nb, scr, lane); continue; } r -= I_IN;
        if (r < I_OUT) { const int kb = r / 32, nb = r % 32;
            transpose_item(a.w_out + (size_t)l * DM * DM, DM, 64 * kb, 32 * nb, (bf16_t*)(wl + WO_OUT), DM, 32 * nb, scr, lane); continue; } r -= I_OUT;
        if (r < I_UP) { const int kb = r / 176, nb = r % 176, pn = nb >> 3, wi = nb & 7; const int src = wi < 4 ? 128 * pn + 32 * wi : FF + 128 * pn + 32 * (wi - 4);
            transpose_item(a.ffn_up + (size_t)l * DM * FF2, FF2, 64 * kb, src, (bf16_t*)(wl + WO_UP), DM, 32 * nb, scr, lane); continue; } r -= I_UP;
        if (r < I_DN) { const int kb = r / 32, nb = r % 32;
            transpose_item(a.ffn_down + (size_t)l * FF * DM, DM, 64 * kb, 32 * nb, (bf16_t*)(wl + WO_DN), FF, 32 * nb, scr, lane); continue; } r -= I_DN;
        { const int g = r >> 3, kb = (r >> 2) & 1, nb = r & 3;
            transpose_item(a.pool_w + (size_t)(l * 4 + g) * 128 * 128, 128, 64 * kb, 32 * nb, (bf16_t*)(wl + WO_PW) + (size_t)g * 128 * 128, 128, 32 * nb, scr, lane); }
    }
}

template <bool WITH_F>
__device__ __forceinline__ void norm_phase(const Args& a, const float* xin, int l, int whichb, const float* gvec, LAS unsigned char* lds, int tid, int lane, int wave, int G) {
    LAS float* gm_l = (LAS float*)lds; LAS float* sh_l = gm_l + 1024;
    const float* part = (const float*)(a.ws + WS_PART);
    bf16_t* XN = (bf16_t*)(a.ws + WS_XN);
    float* LF = (float*)(a.ws + WS_LF);
    f32x4 wf[WITH_F ? 16 : 1][2];
    if (WITH_F) {
        const float* wi = a.w_in + (size_t)l * DM * INC + 1536;
#pragma unroll
        for (int j = 0; j < 4; ++j)
#pragma unroll
            for (int e = 0; e < 4; ++e) { const int k = 4 * lane + 256 * j + e; wf[j * 4 + e][0] = *(const f32x4*)(wi + (size_t)k * INC); wf[j * 4 + e][1] = *(const f32x4*)(wi + (size_t)k * INC + 4); }
    }
    for (int blk = blockIdx.x; blk < MR / 64; blk += G) {
        const int b = blk >> 5;
        __syncthreads();
        for (int k = tid; k < DM; k += 512) { float sh = 0.f, sc = 0.f;
#pragma unroll
            for (int kc = 0; kc < 8; ++kc) { const float* p = part + ((size_t)((kc * 2 + l) * 8 + b)) * 6144 + k; sh += p[whichb * 1024]; sc += p[(whichb + 1) * 1024]; }
            gm_l[k] = gvec[k] * (1.f + sc); sh_l[k] = sh; }
        __syncthreads();
        f32x4 gm[4], sh[4];
#pragma unroll
        for (int j = 0; j < 4; ++j) { gm[j] = *(const LAS f32x4*)(gm_l + 4 * lane + 256 * j); sh[j] = *(const LAS f32x4*)(sh_l + 4 * lane + 256 * j); }
#pragma unroll 2
        for (int i = 0; i < 8; ++i) {
            const int row = blk * 64 + wave * 8 + i;
            const f32x4* xr = (const f32x4*)(xin + (size_t)row * DM) + lane;
            f32x4 v[4]; float s = 0.f;
#pragma unroll
            for (int j = 0; j < 4; ++j) { v[j] = xr[64 * j]; s += (v[j].x * v[j].x + v[j].y * v[j].y) + (v[j].z * v[j].z + v[j].w * v[j].w); }
            const float rstd = 1.f / sqrtf(wave_sum(s) * (1.f / DM) + EPS);
            unsigned long long* o8 = (unsigned long long*)(XN + (size_t)row * DM) + lane;
#pragma unroll
            for (int j = 0; j < 4; ++j) { v[j] = v[j] * rstd * gm[j] + sh[j];
                o8[64 * j] = (unsigned long long)pk_bf16(v[j].x, v[j].y) | ((unsigned long long)pk_bf16(v[j].z, v[j].w) << 32); }
            if (WITH_F) {
                f32x4 d0 = (f32x4){0.f, 0.f, 0.f, 0.f}, d1 = d0;
#pragma unroll
                for (int j = 0; j < 4; ++j)
#pragma unroll
                    for (int e = 0; e < 4; ++e) { d0 += wf[j * 4 + e][0] * v[j][e]; d1 += wf[j * 4 + e][1] * v[j][e]; }
                float dd[8] = {d0[0], d0[1], d0[2], d0[3], d1[0], d1[1], d1[2], d1[3]};
#pragma unroll
                for (int h = 0; h < 8; ++h) dd[h] = wave_sum(dd[h]);
                float mine = dd[0];
#pragma unroll
                for (int h = 1; h < 8; ++h) mine = (lane == h) ? dd[h] : mine;
                if (lane < 8) { const float z = mine + a.b_f[l * NH + lane]; const float lf = fminf(z, 0.f) - log1pf(__expf(-fabsf(z)));
                    LF[((size_t)(b * NH + lane)) * SEQ + (row & (SEQ - 1))] = lf; }
            }
        }
    }
}

__device__ __forceinline__ void final_norm(const Args& a, int lane, int wave, int G) {
    f32x4 g[4];
#pragma unroll
    for (int j = 0; j < 4; ++j) g[j] = *((const f32x4*)a.final_g + lane + 64 * j);
    for (int row = blockIdx.x * 8 + wave; row < MR; row += G * 8) {
        f32x4* xr = (f32x4*)(a.out + (size_t)row * DM) + lane;
        f32x4 v[4]; float s = 0.f;
#pragma unroll
        for (int j = 0; j < 4; ++j) { v[j] = xr[64 * j]; s += (v[j].x * v[j].x + v[j].y * v[j].y) + (v[j].z * v[j].z + v[j].w * v[j].w); }
        const float rstd = 1.f / sqrtf(wave_sum(s) * (1.f / DM) + EPS);
#pragma unroll
        for (int j = 0; j < 4; ++j) xr[64 * j] = v[j] * rstd * g[j];
    }
}

__device__ __forceinline__ int crow(int r, int hi) { return (r & 3) + 8 * (r >> 2) + 4 * hi; }
constexpr int AL_FS = 0, AL_WT = 8192, AL_K = 16384, AL_V = 32768;
__device__ __forceinline__ void attn_unit(const Args& a, int b, int h, int qb, LAS unsigned char* lds, int tid, int lane, int wave) {
    const bf16_t* Q = (const bf16_t*)(a.ws + WS_Q); const bf16_t* K = (const bf16_t*)(a.ws + WS_K); const bf16_t* V = (const bf16_t*)(a.ws + WS_V);
    bf16_t* MIX = (bf16_t*)(a.ws + WS_MIX);
    const float* LF = (const float*)(a.ws + WS_LF) + (size_t)(b * NH + h) * SEQ;
    LAS float* FS = (LAS float*)(lds + AL_FS); LAS float* WT = (LAS float*)(lds + AL_WT);
    const int r32 = lane & 31, hi = lane >> 5;
    const int NT = 4 * (qb + 1);
    __syncthreads();
    {
        const f32x4 v = *((const f32x4*)LF + tid);
        const float tot = (v.x + v.y) + (v.z + v.w); float inc = tot;
#pragma unroll
        for (int o = 1; o < 64; o <<= 1) { const float t = __shfl_up(inc, o); if (lane >= o) inc += t; }
        if (lane == 63) WT[wave] = inc;
        __syncthreads();
        float woff = 0.f;
        for (int w = 0; w < wave; ++w) woff += WT[w];
        const float ex = woff + inc - tot;
        f32x4 o; o.x = ex + v.x; o.y = o.x + v.y; o.z = o.y + v.z; o.w = o.z + v.w;
        *(LAS f32x4*)(FS + 4 * tid) = o * LOG2E;
    }
    const int skv = tid >> 3, sc = tid & 7;
    const size_t rowb = (size_t)b * SEQ;
    const bf16_t* kg = K + (rowb + skv) * AW + h * HD + sc * 8;
    const bf16_t* vg = V + (rowb + skv) * AW + h * HD + sc * 8;
    const int kst = skv * 128 + ((sc ^ ((skv >> 1) & 7)) * 16);
    const int vst = (sc >> 2) * 4096 + (skv >> 3) * 512 + (skv & 7) * 64 + (sc & 3) * 16;
    u32x4 kreg = *(const u32x4*)kg, vreg = *(const u32x4*)vg;
    const int q = qb * 256 + wave * 32 + r32;
    bf16x8 qr[4];
#pragma unroll
    for (int d0 = 0; d0 < 4; ++d0) qr[d0] = *(const bf16x8*)(Q + (rowb + q) * AW + h * HD + d0 * 16 + hi * 8);
    *(LAS u32x4*)(lds + AL_K + kst) = kreg; *(LAS u32x4*)(lds + AL_V + vst) = vreg;
    __syncthreads();
    const float FQ = FS[q];
    float mrun = -INFINITY, lsum = 0.f;
    f32x16 o0 = {}, o1 = {};
    const int qmax = qb * 256 + wave * 32 + 31;
    int koff[4];
#pragma unroll
    for (int d0 = 0; d0 < 4; ++d0) koff[d0] = r32 * 128 + (((2 * d0 + hi) ^ ((r32 >> 1) & 7)) * 16);
    const int voff = ((lane >> 4) & 1) * 32 + (lane & 3) * 8 + (4 * hi + ((lane & 15) >> 2)) * 64;
    for (int t = 0; t < NT; ++t) {
        const int cur = (t & 1) * 8192;
        if (t + 1 < NT) { kreg = *(const u32x4*)(kg + (size_t)(t + 1) * 64 * AW); vreg = *(const u32x4*)(vg + (size_t)(t + 1) * 64 * AW); }
        if (64 * t <= qmax) {
            const LAS unsigned char* Kb = lds + AL_K + cur; const LAS unsigned char* Vb = lds + AL_V + cur;
            f32x16 p0 = {}, p1 = {};
#pragma unroll
            for (int d0 = 0; d0 < 4; ++d0) {
                const bf16x8 k0 = *(const LAS bf16x8*)(Kb + koff[d0]); const bf16x8 k1 = *(const LAS bf16x8*)(Kb + koff[d0] + 32 * 128);
                p0 = __builtin_amdgcn_mfma_f32_32x32x16_bf16(k0, qr[d0], p0, 0, 0, 0);
                p1 = __builtin_amdgcn_mfma_f32_32x32x16_bf16(k1, qr[d0], p1, 0, 0, 0);
            }
            const int kv0 = 64 * t;
#pragma unroll
            for (int j = 0; j < 4; ++j) {
                const f32x4 f0 = *(const LAS f32x4*)(FS + kv0 + 4 * hi + 8 * j), f1 = *(const LAS f32x4*)(FS + kv0 + 32 + 4 * hi + 8 * j);
#pragma unroll
                for (int e = 0; e < 4; ++e) { p0[4 * j + e] += FQ - f0[e]; p1[4 * j + e] += FQ - f1[e]; }
            }
            if (kv0 + 63 > q - r32) {
#pragma unroll
                for (int r = 0; r < 16; ++r) { const int kv = kv0 + crow(r, hi); if (kv > q) p0[r] = -INFINITY; if (kv + 32 > q) p1[r] = -INFINITY; }
            }
            float rm = fmaxf(p0[0], p1[0]);
#pragma unroll
            for (int r = 1; r < 16; ++r) rm = fmaxf(rm, fmaxf(p0[r], p1[r]));
            rm = fmaxf(rm, __shfl_xor(rm, 32));
            const float mnew = fmaxf(mrun, rm);
            const float alpha = __builtin_amdgcn_exp2f(mrun - mnew);
            mrun = mnew;
            float ps = 0.f;
#pragma unroll
            for (int r = 0; r < 16; ++r) { p0[r] = __builtin_amdgcn_exp2f(p0[r] - mnew); p1[r] = __builtin_amdgcn_exp2f(p1[r] - mnew); ps += p0[r] + p1[r]; }
            lsum = lsum * alpha + ps;
#pragma unroll
            for (int r = 0; r < 16; ++r) { o0[r] *= alpha; o1[r] *= alpha; }
            u32x4 pw[4];
#pragma unroll
            for (int e = 0; e < 4; ++e) { pw[0][e] = pk_bf16(p0[2 * e], p0[2 * e + 1]); pw[1][e] = pk_bf16(p0[8 + 2 * e], p0[9 + 2 * e]);
                                          pw[2][e] = pk_bf16(p1[2 * e], p1[2 * e + 1]); pw[3][e] = pk_bf16(p1[8 + 2 * e], p1[9 + 2 * e]); }
#pragma unroll
            for (int ks = 0; ks < 4; ++ks) {
                const bf16x8 pf = __builtin_bit_cast(bf16x8, pw[ks]);
                typedef short v4i16_t __attribute__((ext_vector_type(4)));
                const s16x4 a0 = __builtin_bit_cast(s16x4, __builtin_amdgcn_ds_read_tr16_b64_v4i16((LAS v4i16_t*)(Vb + voff + ks * 1024)));
                const s16x4 a1 = __builtin_bit_cast(s16x4, __builtin_amdgcn_ds_read_tr16_b64_v4i16((LAS v4i16_t*)(Vb + voff + ks * 1024 + 512)));
                const s16x4 c0 = __builtin_bit_cast(s16x4, __builtin_amdgcn_ds_read_tr16_b64_v4i16((LAS v4i16_t*)(Vb + voff + 4096 + ks * 1024)));
                const s16x4 c1 = __builtin_bit_cast(s16x4, __builtin_amdgcn_ds_read_tr16_b64_v4i16((LAS v4i16_t*)(Vb + voff + 4096 + ks * 1024 + 512)));
                const bf16x8 v0 = (bf16x8){a0[0], a0[1], a0[2], a0[3], a1[0], a1[1], a1[2], a1[3]};
                const bf16x8 v1 = (bf16x8){c0[0], c0[1], c0[2], c0[3], c1[0], c1[1], c1[2], c1[3]};
                o0 = __builtin_amdgcn_mfma_f32_32x32x16_bf16(v0, pf, o0, 0, 0, 0);
                o1 = __builtin_amdgcn_mfma_f32_32x32x16_bf16(v1, pf, o1, 0, 0, 0);
            }
        }
        if (t + 1 < NT) { const int nxt = ((t + 1) & 1) * 8192; *(LAS u32x4*)(lds + AL_K + nxt + kst) = kreg; *(LAS u32x4*)(lds + AL_V + nxt + vst) = vreg; }
        __syncthreads();
    }
    lsum += __shfl_xor(lsum, 32);
    const float inv = 1.f / lsum;
    bf16_t* orow = MIX + (rowb + q) * DM + h * HD + 4 * hi;
#pragma unroll
    for (int j = 0; j < 4; ++j) {
        u32x2 w0, w1;
        w0.x = pk_bf16(o0[4 * j] * inv, o0[4 * j + 1] * inv); w0.y = pk_bf16(o0[4 * j + 2] * inv, o0[4 * j + 3] * inv);
        w1.x = pk_bf16(o1[4 * j] * inv, o1[4 * j + 1] * inv); w1.y = pk_bf16(o1[4 * j + 2] * inv, o1[4 * j + 3] * inv);
        *(u32x2*)(orow + 8 * j) = w0; *(u32x2*)(orow + 32 + 8 * j) = w1;
    }
}

__device__ __forceinline__ void pool_unit(const Args& a, int l, int rb, int g, int lane, int wave) {
    const bf16_t* U = (const bf16_t*)(a.ws + WS_U); bf16_t* MIX = (bf16_t*)(a.ws + WS_MIX);
    const bf16_t* PW = (const bf16_t*)(a.ws + WS_W0 + (size_t)l * WS_WL + WO_PW) + (size_t)g * 128 * 128;
    const int fr = lane & 15, fq = lane >> 4;
    const int row = rb * 128 + wave * 16 + fr, t = row & (SEQ - 1);
    const int w = 2 << g; const int cnt = (t + 1) < w ? (t + 1) : w; const float rc = 1.f / (float)cnt;
    bf16x8 af[4];
#pragma unroll
    for (int ks = 0; ks < 4; ++ks) {
        const bf16_t* up = U + (size_t)row * AW + 128 * g + 32 * ks + 8 * fq;
        float s[8];
        const u32x4 self = *(const u32x4*)up;
#pragma unroll
        for (int e = 0; e < 4; ++e) { s[2 * e] = bf_lo(self[e]); s[2 * e + 1] = bf_hi(self[e]); }
        for (int j = 1; j < w; ++j) { if (j < cnt) { const u32x4 v = *(const u32x4*)(up - (size_t)j * AW);
#pragma unroll
                for (int e = 0; e < 4; ++e) { s[2 * e] += bf_lo(v[e]); s[2 * e + 1] += bf_hi(v[e]); } } }
        u32x4 pk;
#pragma unroll
        for (int e = 0; e < 4; ++e) pk[e] = pk_bf16(s[2 * e] * rc - bf_lo(self[e]), s[2 * e + 1] * rc - bf_hi(self[e]));
        af[ks] = __builtin_bit_cast(bf16x8, pk);
    }
#pragma unroll
    for (int nt = 0; nt < 8; ++nt) {
        f32x4 acc = (f32x4){0.f, 0.f, 0.f, 0.f};
#pragma unroll
        for (int ks = 0; ks < 4; ++ks) { const bf16x8 bfr = *(const bf16x8*)(PW + (size_t)(16 * nt + fr) * 128 + 32 * ks + 8 * fq);
            acc = __builtin_amdgcn_mfma_f32_16x16x32_bf16(bfr, af[ks], acc, 0, 0, 0); }
        const int n0 = 128 * g + 16 * nt + 4 * fq;
        const f32x4 ps = *(const f32x4*)(a.pool_scale + l * 512 + n0);
        u32x2 o; o.x = pk_bf16(acc[0] * ps[0], acc[1] * ps[1]); o.y = pk_bf16(acc[2] * ps[2], acc[3] * ps[3]);
        *(u32x2*)(MIX + (size_t)row * DM + 512 + n0) = o;
    }
}

__device__ __forceinline__ void conv_fixup(const Args& a, int l, int pm, int tid) {
    const float* raw = (const float*)(a.ws + WS_RAW); bf16_t* Gb = (bf16_t*)(a.ws + WS_G);
    const float* cw = a.conv_w + (size_t)l * 3 * FF2; const float* cb = a.conv_b + (size_t)l * FF2;
    for (int i = tid; i < 4 * 2 * (FF / 4); i += 512) {
        const int c4 = i % (FF / 4), rr = (i / (FF / 4)) & 1, rg = i / (2 * (FF / 4));
        const int range = pm * 4 + rg, row = range * 64 + rr, ch = 4 * c4;
        const bool first = ((range * 64) & (SEQ - 1)) == 0;
        f32x4 cv[2];
#pragma unroll
        for (int bj = 0; bj < 2; ++bj) {
            const int c = bj * FF + ch;
            const f32x4 cur = *(const f32x4*)(raw + ((size_t)range * 4 + rr) * FF2 + c);
            f32x4 p1, p2; const f32x4 z = (f32x4){0.f, 0.f, 0.f, 0.f};
            if (rr == 0) { p1 = first ? z : *(const f32x4*)(raw + ((size_t)(range - 1) * 4 + 3) * FF2 + c); p2 = first ? z : *(const f32x4*)(raw + ((size_t)(range - 1) * 4 + 2) * FF2 + c); }
            else { p1 = *(const f32x4*)(raw + ((size_t)range * 4 + 0) * FF2 + c); p2 = first ? z : *(const f32x4*)(raw + ((size_t)(range - 1) * 4 + 3) * FF2 + c); }
            cv[bj] = *(const f32x4*)(cb + c) + *(const f32x4*)(cw + c) * p2 + *(const f32x4*)(cw + FF2 + c) * p1 + *(const f32x4*)(cw + 2 * FF2 + c) * cur;
        }
        f32x4 gg;
#pragma unroll
        for (int e = 0; e < 4; ++e) { const float x = cv[0][e]; gg[e] = x * __builtin_amdgcn_rcpf(1.f + __builtin_amdgcn_exp2f(-LOG2E * x)) * cv[1][e]; }
        u32x2 w; w.x = pk_bf16(gg[0], gg[1]); w.y = pk_bf16(gg[2], gg[3]);
        *(u32x2*)(Gb + (size_t)row * FF + ch) = w;
    }
}

__global__ void __launch_bounds__(512, 2) fwd_kernel(Args a) {
    extern __shared__ __attribute__((aligned(16))) unsigned char lds_raw[];
    LAS unsigned char* lds = (LAS unsigned char*)lds_raw;
    cg::grid_group grid = cg::this_grid();
    const int tid0 = threadIdx.x, G = gridDim.x;
    const int lo = a.ph_lo, hi = a.ph_hi;
    int ph = 0;
#define SEAM() do { if (lo <= ph && ph + 1 < hi) grid.sync(); ++ph; } while (0)
#define RUN() (lo <= ph && ph < hi)
#ifndef PH_MASK
#define PH_MASK 0x3ff
#endif
#define PHM(k) ((PH_MASK >> (k)) & 1)
#define FRESH() int tid = tid0, l = l0; asm volatile("" : "+v"(tid), "+s"(l)); const int lane = tid & 63, wave = __builtin_amdgcn_readfirstlane(tid >> 6); (void)lane; (void)wave;
    if (PHM(0) && RUN()) { const int l0 = 0; FRESH(); prologue(a, lds, tid, lane, wave, G); }
    SEAM();
    for (int l0 = 0; l0 < NL; ++l0) {
        if (PHM(1) && RUN()) { FRESH(); const float* xres = (l == 0) ? a.x : a.out; norm_phase<true>(a, xres, l, 0, a.n1g + l * DM, lds, tid, lane, wave, G); }
        SEAM();
        if (PHM(2) && RUN()) { FRESH(); unsigned char* wl = a.ws + WS_W0 + (size_t)l * WS_WL; pg8::Gemm g{(const bf16_t*)(a.ws + WS_XN), (const bf16_t*)(wl + WO_IN), MR, 2048, DM}; pg8::StaticOrder S; S.init(MR, 2048, G, (int)blockIdx.x);
            pg8::EpiBf16 E{(bf16_t*)(a.ws + WS_Q), AW, AW, (size_t)MR * AW, QSCALE};
            pg8::gemm_phase<pg8::EpiBf16, pg8::StaticOrder, true, true>(lds, g, S, E, tid); }
        SEAM();
        if (RUN()) { FRESH();
            if (PHM(3)) for (int p = blockIdx.x; p < NB * NH * 4; p += G) { const int bh = p >> 2, s = p & 3;
                attn_unit(a, bh >> 3, bh & 7, 7 - s, lds, tid, lane, wave);
                attn_unit(a, bh >> 3, bh & 7, s, lds, tid, lane, wave); }
            if (PHM(4)) for (int p = blockIdx.x; p < (MR / 128) * 4; p += G) pool_unit(a, l, p >> 2, p & 3, lane, wave);
        }
        SEAM();
        if (PHM(5) && RUN()) { FRESH(); unsigned char* wl = a.ws + WS_W0 + (size_t)l * WS_WL; const float* xres = (l == 0) ? a.x : a.out; pg8::Gemm g{(const bf16_t*)(a.ws + WS_MIX), (const bf16_t*)(wl + WO_OUT), MR, DM, DM}; pg8::StaticOrder S; S.init(MR, DM, G, (int)blockIdx.x);
            pg8::EpiRes E{xres, a.out, (const float*)(a.ws + WS_PART), l, 2};
            pg8::gemm_phase<pg8::EpiRes, pg8::StaticOrder, true, true>(lds, g, S, E, tid); }
        SEAM();
        if (PHM(6) && RUN()) { FRESH(); norm_phase<false>(a, a.out, l, 3, a.n2g + l * DM, lds, tid, lane, wave, G); }
        SEAM();
        if (PHM(7) && RUN()) { FRESH(); unsigned char* wl = a.ws + WS_W0 + (size_t)l * WS_WL; pg8::Gemm g{(const bf16_t*)(a.ws + WS_XN), (const bf16_t*)(wl + WO_UP), MR, FF2, DM}; pg8::StaticOrder S; S.init(MR, FF2, G, (int)blockIdx.x);
            pg8::EpiConv E{(bf16_t*)(a.ws + WS_G), (float*)(a.ws + WS_RAW), a.conv_w + (size_t)l * 3 * FF2, a.conv_b + (size_t)l * FF2};
            pg8::gemm_phase<pg8::EpiConv, pg8::StaticOrder, true, true>(lds, g, S, E, tid); }
        SEAM();
        if (PHM(8) && RUN()) { FRESH(); unsigned char* wl = a.ws + WS_W0 + (size_t)l * WS_WL; pg8::Gemm g{(const bf16_t*)(a.ws + WS_G), (const bf16_t*)(wl + WO_DN), MR, DM, FF}; pg8::StaticOrder S; S.init(MR, DM, G, (int)blockIdx.x);
            pg8::Unit u; for (int i = 0; S.next(i, u); ++i) conv_fixup(a, l, u.pm, tid);
            __threadfence(); __syncthreads();
            pg8::EpiRes E{a.out, a.out, (const float*)(a.ws + WS_PART), l, 5};
            pg8::gemm_phase<pg8::EpiRes, pg8::StaticOrder, true, true>(lds, g, S, E, tid); }
        SEAM();
    }
    if (PHM(9) && RUN()) { const int l0 = 0; FRESH(); final_norm(a, lane, wave, G); }
#undef SEAM
#undef RUN
}

#ifndef N_LAUNCH_MODE
#define N_LAUNCH_MODE 1
#endif
extern "C" void kernel_launch(void* const* d_in, const int* in_sizes, int n_in, void* d_out, int out_size, void* d_ws, size_t ws_size, hipStream_t stream) {
    static int grid = 0;
    if (grid == 0) {
        if (n_in != 16 || out_size != MR * DM || ws_size < WS_END) { fprintf(stderr, "kernel_launch: unexpected shapes (n_in %d out %d ws %zu)\n", n_in, out_size, ws_size); grid = -1; return; }
        int dev = 0, cus = 0, per_cu = 0;
        hipGetDevice(&dev); hipDeviceGetAttribute(&cus, hipDeviceAttributeMultiprocessorCount, dev);
        if (hipFuncSetAttribute((const void*)fwd_kernel, hipFuncAttributeMaxDynamicSharedMemorySize, LDS_BYTES) != hipSuccess) { fprintf(stderr, "kernel_launch: hipFuncSetAttribute failed\n"); grid = -1; return; }
        if (hipOccupancyMaxActiveBlocksPerMultiprocessor(&per_cu, (const void*)fwd_kernel, 512, LDS_BYTES) != hipSuccess || per_cu < 1) { fprintf(stderr, "kernel_launch: occupancy query says %d\n", per_cu); (void)hipGetLastError(); per_cu = 1; }
        grid = cus * 1;
        if (grid > cus * per_cu) grid = cus * per_cu;
    }
    if (grid < 0) return;
    Args a{};
    a.x = (const float*)d_in[0]; a.c = (const float*)d_in[1]; a.mod_w = (const float*)d_in[2]; a.mod_b = (const float*)d_in[3]; a.n1g = (const float*)d_in[4]; a.n2g = (const float*)d_in[5];
    a.w_in = (const float*)d_in[6]; a.b_f = (const float*)d_in[7]; a.pool_w = (const float*)d_in[8]; a.pool_scale = (const float*)d_in[9]; a.w_out = (const float*)d_in[10];
    a.ffn_up = (const float*)d_in[11]; a.conv_w = (const float*)d_in[12]; a.conv_b = (const float*)d_in[13]; a.ffn_down = (const float*)d_in[14]; a.final_g = (const float*)d_in[15];
    a.out = (float*)d_out; a.ws = (unsigned char*)d_ws;
    constexpr int NPH = 1 + 7 * NL + 1;
#if N_LAUNCH_MODE == 1
    a.ph_lo = 0; a.ph_hi = NPH;
    void* args[] = {&a};
    hipError_t e = hipLaunchCooperativeKernel((const void*)fwd_kernel, dim3(grid), dim3(512), args, LDS_BYTES, stream);
    if (e != hipSuccess) fprintf(stderr, "cooperative launch failed: %s (grid %d)\n", hipGetErrorString(e), grid);
#else
    for (int p = 0; p < NPH; ++p) { a.ph_lo = p; a.ph_hi = p + 1; hipLaunchKernelGGL(fwd_kernel, dim3(grid), dim3(512), LDS_BYTES, stream, a); }
#endif
}
```

```cpp
#include <hip/hip_runtime.h>
#include <hip/hip_cooperative_groups.h>
#include <cstdio>
#include <cstdint>
namespace cg = cooperative_groups;
namespace pg8 {
#define PG8_LAS __attribute__((address_space(3)))
typedef unsigned short bf16_t;
typedef short bf16x8 __attribute__((ext_vector_type(8)));
typedef float f32x4 __attribute__((ext_vector_type(4)));
typedef unsigned u32x4 __attribute__((ext_vector_type(4)));
constexpr int BM = 256, BK = 64, HALF = 128, HTB = HALF * BK * 2  , STAGE_BYTES = 8 * HTB, NXCD = 8, WGM = 8;

__host__ __device__ __forceinline__ int lds_byte(int r, int c) { const int st = (r >> 4) * 2 + (c >> 5), rr = r & 15, cc = c & 31, ob = rr * 64 + cc * 2; return st * 1024 + (ob ^ (((ob >> 9) & 1) << 5)); }
__host__ __device__ __forceinline__ void stage_rc(int b, int& R, int& C) { const int st = b / 1024, sb = b % 1024, swz = sb ^ (((sb >> 9) & 1) << 5); R = (st >> 1) * 16 + swz / 64; C = (st & 1) * 32 + (swz % 64) / 2; }
__host__ __device__ __forceinline__ int perm32(int rho) { const int n = rho >> 4, i = rho & 15; return 8 * (i >> 2) + 4 * n + (i & 3); }

struct Unit { int pm, pn; };
struct Gemm { const bf16_t* A; const bf16_t* Bt; int M, N, K; };

struct StaticOrder {
    int nM, nN, nwg, G, c;
    __host__ __device__ void init(int M, int N, int G_, int c_) { nM = M / BM; nN = N / BM; nwg = nM * nN; G = G_; c = c_; }
    __host__ __device__ bool next(int i, Unit& u) const {
        const long L = (long)i * G + c; if (L >= nwg) return false;
        int wgid = (int)L; { const int q = nwg / NXCD, r = nwg % NXCD, xcd = wgid % NXCD, off = wgid / NXCD; wgid = (xcd < r ? xcd * (q + 1) : r * (q + 1) + (xcd - r) * q) + off; }
        const int nig = WGM * nN, gid = wgid / nig, fm = gid * WGM, gsz = (nM - fm) < WGM ? (nM - fm) : WGM;
        u.pm = fm + ((wgid % nig) % gsz); u.pn = (wgid % nig) / gsz; return true;
    }
    __device__ __forceinline__ void a_ready(const Unit&) const {}
    __device__ __forceinline__ void done(const Unit&) const {}
};

__device__ __forceinline__ unsigned cvt_pk_bf16(float lo, float hi) { unsigned r; asm volatile("v_cvt_pk_bf16_f32 %0, %1, %2" : "=v"(r) : "v"(lo), "v"(hi)); return r; }
typedef unsigned u32x2 __attribute__((ext_vector_type(2)));
struct EpiBf16 {
    static constexpr bool PERM = true, AFTER_DRAIN = false;
    bf16_t* O; int ldc; int split_cols; size_t split_stride; float scale0;
    __device__ __forceinline__ void operator()(const f32x4 (&acc)[2][2][4][2], const Unit& u, int wr, int wc, int fr, int fq) const {
        const int row0 = u.pm * BM + wr * 64 + fr; int colt = u.pn * BM; bf16_t* base = O;
        float sc = 1.f; { const int t = colt / split_cols; base += (size_t)t * split_stride; colt -= t * split_cols; if (t == 0) sc = scale0; }
        const int col0 = colt + wc * 32 + 8 * fq;
#pragma unroll
        for (int ai = 0; ai < 2; ++ai)
#pragma unroll
            for (int m = 0; m < 4; ++m) { bf16_t* rowp = base + (size_t)(row0 + ai * HALF + m * 16) * ldc + col0;
#pragma unroll
                for (int bj = 0; bj < 2; ++bj) { f32x4 v0 = acc[ai][bj][m][0] * sc, v1 = acc[ai][bj][m][1] * sc;
                    u32x4 w; w.x = cvt_pk_bf16(v0[0], v0[1]); w.y = cvt_pk_bf16(v0[2], v0[3]); w.z = cvt_pk_bf16(v1[0], v1[1]); w.w = cvt_pk_bf16(v1[2], v1[3]);
                    *(u32x4*)(rowp + bj * HALF) = w; } }
    }
};
struct EpiRes {
    static constexpr bool PERM = false, AFTER_DRAIN = false;
    const float* base; float* out; const float* part; int l, which;
    __device__ __forceinline__ void operator()(const f32x4 (&acc)[2][2][4][2], const Unit& u, int wr, int wc, int fr, int fq) const {
        const int b = u.pm >> 3; const int col0 = u.pn * BM + wc * 32 + 4 * fq;
        f32x4 gv[2][2];
#pragma unroll
        for (int bj = 0; bj < 2; ++bj)
#pragma unroll
            for (int n = 0; n < 2; ++n) { f32x4 s = (f32x4){0.f, 0.f, 0.f, 0.f};
#pragma unroll
                for (int kc = 0; kc < 8; ++kc) s += *(const f32x4*)(part + ((size_t)((kc * 2 + l) * 8 + b)) * 6144 + which * 1024 + col0 + bj * HALF + n * 16);
                gv[bj][n] = s; }
#pragma unroll
        for (int ai = 0; ai < 2; ++ai)
#pragma unroll
            for (int m = 0; m < 4; ++m) { const size_t off = (size_t)(u.pm * BM + ai * HALF + wr * 64 + m * 16 + fr) * 1024 + col0;
#pragma unroll
                for (int bj = 0; bj < 2; ++bj)
#pragma unroll
                    for (int n = 0; n < 2; ++n) { const f32x4 bs = *(const f32x4*)(base + off + bj * HALF + n * 16);
                        *(f32x4*)(out + off + bj * HALF + n * 16) = bs + gv[bj][n] * acc[ai][bj][m][n]; }
                if (m & 1) asm volatile("" ::: "memory"); }
    }
};
__device__ __forceinline__ float dpp_ror1(float v) { return __builtin_bit_cast(float, __builtin_amdgcn_mov_dpp(__builtin_bit_cast(int, v), 0x121, 0xf, 0xf, true)); }
__device__ __forceinline__ float dpp_ror2(float v) { return __builtin_bit_cast(float, __builtin_amdgcn_mov_dpp(__builtin_bit_cast(int, v), 0x122, 0xf, 0xf, true)); }
struct EpiConv {
    static constexpr bool PERM = true, AFTER_DRAIN = false;
    bf16_t* Gout; float* raw; const float* cw; const float* cb;
    __device__ __forceinline__ void operator()(const f32x4 (&acc)[2][2][4][2], const Unit& u, int wr, int wc, int fr, int fq) const {
        const int ch0 = u.pn * 128 + wc * 32 + 8 * fq;
#pragma unroll
        for (int n = 0; n < 2; ++n) {
            const int ch = ch0 + 4 * n;
            f32x4 w0[2], w1[2], w2[2], bb[2];
#pragma unroll
            for (int bj = 0; bj < 2; ++bj) { const int c = bj * 2816 + ch;
                w0[bj] = *(const f32x4*)(cw + c); w1[bj] = *(const f32x4*)(cw + 5632 + c); w2[bj] = *(const f32x4*)(cw + 2 * 5632 + c); bb[bj] = *(const f32x4*)(cb + c); }
#pragma unroll
            for (int ai = 0; ai < 2; ++ai)
#pragma unroll
                for (int m = 0; m < 4; ++m) {
                    const int row = u.pm * BM + ai * HALF + wr * 64 + m * 16 + fr;
                    f32x4 cv[2];
#pragma unroll
                    for (int bj = 0; bj < 2; ++bj) {
                        const f32x4 cur = acc[ai][bj][m][n]; const f32x4 prv = acc[ai][bj][m > 0 ? m - 1 : 0][n];
                        f32x4 p1, p2;
#pragma unroll
                        for (int e = 0; e < 4; ++e) { const float c1 = dpp_ror1(cur[e]), c2 = dpp_ror2(cur[e]), q1 = dpp_ror1(prv[e]), q2 = dpp_ror2(prv[e]);
                            p1[e] = fr >= 1 ? c1 : q1; p2[e] = fr >= 2 ? c2 : q2; }
                        cv[bj] = bb[bj] + w0[bj] * p2 + w1[bj] * p1 + w2[bj] * cur;
                        if (m == 0 && fr < 2) *(f32x4*)(raw + ((size_t)(row >> 6) * 4 + fr) * 5632 + bj * 2816 + ch) = cur;
                        if (m == 3 && fr >= 14) *(f32x4*)(raw + ((size_t)(row >> 6) * 4 + (fr - 12)) * 5632 + bj * 2816 + ch) = cur;
                    }
                    if (!(m == 0 && fr < 2)) {
                        f32x4 g;
#pragma unroll
                        for (int e = 0; e < 4; ++e) { const float x = cv[0][e]; g[e] = x * __builtin_amdgcn_rcpf(1.f + __builtin_amdgcn_exp2f(-1.4426950408889634f * x)) * cv[1][e]; }
                        u32x2 w; w.x = cvt_pk_bf16(g[0], g[1]); w.y = cvt_pk_bf16(g[2], g[3]);
                        *(u32x2*)(Gout + (size_t)row * 2816 + ch) = w;
                    }
                }
        }
    }
};
template <class Epi, class Sched, bool ALIGN_EPI = false, bool SP2 = false>
__device__ __forceinline__ void gemm_phase(PG8_LAS unsigned char* lds, const Gemm g, const Sched& S, const Epi& E, const int tid) {
    const int wid = __builtin_amdgcn_readfirstlane(tid >> 6), lane = tid & 63, wr = wid >> 2, wc = wid & 3, fr = lane & 15, fq = lane >> 4;
    const int K = g.K, nt = K / BK;
    unsigned voffA[2], voffB[2];
#pragma unroll
    for (int i = 0; i < 2; ++i) { int R, C; stage_rc(tid * 16 + i * 8192, R, C); const int Rb = Epi::PERM ? ((R & ~31) + perm32(R & 31)) : R;
        voffA[i] = (unsigned)(R * K + C) * 2u; voffB[i] = (unsigned)(Rb * K + C) * 2u; }
    const size_t kstep = (size_t)(BK * 2);
    const size_t hstep = (size_t)HALF * K * 2;
    const size_t tstep = 2 * hstep;
    const unsigned ldsw = (unsigned)wid * 1024u;
    const int aoff = lds_byte(wr * 64 + fr, fq * 8), boff = lds_byte(wc * 32 + fr, fq * 8);
#define PG8_SA(b, h) (((b) * 2 + (h)) * HTB)
#define PG8_SB(b, h) ((4 + (b) * 2 + (h)) * HTB)
#define PG8_STAGE(bufoff, gbase, voff) do { _Pragma("unroll") for (int _i = 0; _i < 2; ++_i) \
        __builtin_amdgcn_global_load_lds((const unsigned*)((const char*)(gbase) + (voff)[_i]), (PG8_LAS unsigned*)(lds + (bufoff) + ldsw + _i * 8192), 16, 0, 0); } while (0)
#define PG8_LDA(dst, b, h) do { _Pragma("unroll") for (int m = 0; m < 4; ++m) _Pragma("unroll") for (int k = 0; k < 2; ++k) dst[m][k] = *(const PG8_LAS bf16x8*)(lds + PG8_SA(b, h) + aoff + m * 2048 + k * 1024); } while (0)
#define PG8_LDB(dst, b, h) do { _Pragma("unroll") for (int n = 0; n < 2; ++n) _Pragma("unroll") for (int k = 0; k < 2; ++k) dst[n][k] = *(const PG8_LAS bf16x8*)(lds + PG8_SB(b, h) + boff + n * 2048 + k * 1024); } while (0)
#define PG8_MMA(ai, bj, At, Bt) do { __builtin_amdgcn_s_setprio(1); _Pragma("unroll") for (int m = 0; m < 4; ++m) _Pragma("unroll") for (int n = 0; n < 2; ++n) _Pragma("unroll") for (int k = 0; k < 2; ++k) \
        acc[ai][bj][m][n] = __builtin_amdgcn_mfma_f32_16x16x32_bf16(Bt[n][k], At[m][k], acc[ai][bj][m][n], 0, 0, 0); __builtin_amdgcn_s_setprio(0); } while (0)
#define PG8_WAIT_V(n) asm volatile("s_waitcnt vmcnt(" #n ")" ::: "memory")
#define PG8_WAIT_L(n) asm volatile("s_waitcnt lgkmcnt(" #n ")" ::: "memory")
#define PG8_BAR __builtin_amdgcn_s_barrier()
#define PG8_SCHED __builtin_amdgcn_sched_barrier(0)
    Unit cur, nxt; int ui = 0;
    if (!S.next(0, cur)) return;
    f32x4 acc[2][2][4][2];
#pragma unroll
    for (int a = 0; a < 2; ++a)
#pragma unroll
        for (int b = 0; b < 2; ++b)
#pragma unroll
            for (int m = 0; m < 4; ++m)
#pragma unroll
                for (int n = 0; n < 2; ++n) acc[a][b][m][n] = (f32x4){0.f, 0.f, 0.f, 0.f};
    bf16x8 At[4][2], B0[2][2], B1[2][2];
    const char* cA = (const char*)g.A + (size_t)cur.pm * tstep; const char* cB = (const char*)g.Bt + (size_t)cur.pn * tstep;
    S.a_ready(cur);
    if constexpr (SP2) {
        PG8_STAGE(PG8_SB(0, 0), cB, voffB); PG8_STAGE(PG8_SB(0, 1), cB + hstep, voffB); PG8_STAGE(PG8_SA(0, 0), cA, voffA); PG8_STAGE(PG8_SA(0, 1), cA + hstep, voffA);
        if (wr == 1) PG8_BAR;
        PG8_WAIT_V(2); PG8_BAR;
        PG8_STAGE(PG8_SB(1, 0), cB + kstep, voffB); PG8_STAGE(PG8_SA(1, 0), cA + kstep, voffA); PG8_STAGE(PG8_SB(1, 1), cB + hstep + kstep, voffB);
        PG8_WAIT_V(6); PG8_BAR;
    } else {
        PG8_STAGE(PG8_SB(0, 0), cB, voffB); PG8_STAGE(PG8_SA(0, 0), cA, voffA); PG8_STAGE(PG8_SB(0, 1), cB + hstep, voffB); PG8_STAGE(PG8_SA(0, 1), cA + hstep, voffA);
        if (wr == 1) PG8_BAR;
        PG8_WAIT_V(4); PG8_BAR;
        PG8_STAGE(PG8_SB(1, 0), cB + kstep, voffB); PG8_STAGE(PG8_SA(1, 0), cA + kstep, voffA); PG8_STAGE(PG8_SB(1, 1), cB + hstep + kstep, voffB);
        PG8_WAIT_V(6); PG8_BAR;
    }
    for (;;) {
        const bool has_next = S.next(ui + 1, nxt);
        const char* nA = has_next ? (const char*)g.A + (size_t)nxt.pm * tstep : cA; const char* nB = has_next ? (const char*)g.Bt + (size_t)nxt.pn * tstep : cB;
        for (int t = 0; t < nt; t += 2) {
            const bool last = (t == nt - 2);
            const char* a1 = cA + (size_t)(t + 1) * kstep;
            const char* a2 = last ? nA : cA + (size_t)(t + 2) * kstep; const char* b2 = last ? nB : cB + (size_t)(t + 2) * kstep;
            const char* a3 = a2 + kstep; const char* b3 = b2 + kstep;
            if (last && has_next) S.a_ready(nxt);
            if constexpr (SP2) {
            PG8_LDB(B0, 0, 0); PG8_LDB(B1, 0, 1); PG8_SCHED; PG8_LDA(At, 0, 0); PG8_STAGE(PG8_SA(1, 1), a1 + hstep, voffA);
            PG8_WAIT_V(8); PG8_WAIT_L(0); PG8_BAR; PG8_MMA(0, 0, At, B0); PG8_MMA(0, 1, At, B1); PG8_BAR; PG8_SCHED;
            PG8_LDA(At, 0, 1); PG8_STAGE(PG8_SB(0, 0), b2, voffB); PG8_STAGE(PG8_SB(0, 1), b2 + hstep, voffB); PG8_STAGE(PG8_SA(0, 0), a2, voffA);
            PG8_WAIT_V(8); PG8_WAIT_L(0); PG8_BAR; PG8_MMA(1, 0, At, B0); PG8_MMA(1, 1, At, B1); PG8_BAR; PG8_SCHED;
            PG8_LDB(B0, 1, 0); PG8_LDB(B1, 1, 1); PG8_SCHED; PG8_LDA(At, 1, 0); PG8_STAGE(PG8_SA(0, 1), a2 + hstep, voffA);
            PG8_WAIT_V(8); PG8_WAIT_L(0); PG8_BAR; PG8_MMA(0, 0, At, B0); PG8_MMA(0, 1, At, B1); PG8_BAR; PG8_SCHED;
            PG8_LDA(At, 1, 1); PG8_STAGE(PG8_SB(1, 0), b3, voffB); PG8_STAGE(PG8_SB(1, 1), b3 + hstep, voffB); PG8_STAGE(PG8_SA(1, 0), a3, voffA);
            PG8_WAIT_V(8); PG8_WAIT_L(0); PG8_BAR; PG8_MMA(1, 0, At, B0); PG8_MMA(1, 1, At, B1); PG8_BAR; PG8_SCHED;
            } else {
            PG8_LDB(B0, 0, 0); PG8_SCHED; PG8_LDA(At, 0, 0); PG8_STAGE(PG8_SA(1, 1), a1 + hstep, voffA);
            PG8_WAIT_L(8); PG8_BAR; PG8_WAIT_L(0); PG8_MMA(0, 0, At, B0); PG8_BAR; PG8_SCHED;
            PG8_LDB(B1, 0, 1); PG8_STAGE(PG8_SB(0, 0), b2, voffB);
            PG8_BAR; PG8_WAIT_L(0); PG8_MMA(0, 1, At, B1); PG8_BAR;
            PG8_LDA(At, 0, 1); PG8_STAGE(PG8_SA(0, 0), a2, voffA);
            PG8_BAR; PG8_WAIT_L(0); PG8_MMA(1, 0, At, B0); PG8_BAR; PG8_SCHED;
            PG8_STAGE(PG8_SB(0, 1), b2 + hstep, voffB);
            PG8_WAIT_V(6); PG8_BAR; PG8_MMA(1, 1, At, B1); PG8_BAR;
            PG8_LDB(B0, 1, 0); PG8_SCHED; PG8_LDA(At, 1, 0); PG8_STAGE(PG8_SA(0, 1), a2 + hstep, voffA);
            PG8_WAIT_L(8); PG8_BAR; PG8_WAIT_L(0); PG8_MMA(0, 0, At, B0); PG8_BAR; PG8_SCHED;
            PG8_LDB(B1, 1, 1); PG8_STAGE(PG8_SB(1, 0), b3, voffB);
            PG8_BAR; PG8_WAIT_L(0); PG8_MMA(0, 1, At, B1); PG8_BAR;
            PG8_LDA(At, 1, 1); PG8_STAGE(PG8_SA(1, 0), a3, voffA);
            PG8_BAR; PG8_WAIT_L(0); PG8_MMA(1, 0, At, B0); PG8_BAR; PG8_SCHED;
            PG8_STAGE(PG8_SB(1, 1), b3 + hstep, voffB);
            PG8_WAIT_V(6); PG8_BAR; PG8_MMA(1, 1, At, B1); PG8_BAR;
            }
        }
        if constexpr (ALIGN_EPI) { if (wr == 0) PG8_BAR; }
        if constexpr (!Epi::AFTER_DRAIN) { E(acc, cur, wr, wc, fr, fq); S.done(cur); }
        if (!has_next) break;
#pragma unroll
        for (int a = 0; a < 2; ++a)
#pragma unroll
            for (int b = 0; b < 2; ++b)
#pragma unroll
                for (int m = 0; m < 4; ++m)
#pragma unroll
                    for (int n = 0; n < 2; ++n) acc[a][b][m][n] = (f32x4){0.f, 0.f, 0.f, 0.f};
        cur = nxt; cA = nA; cB = nB; ++ui;
        if constexpr (ALIGN_EPI) { if (wr == 1) PG8_BAR; }
    }
    PG8_WAIT_V(0);
    if constexpr (!ALIGN_EPI) { if (wr == 0) PG8_BAR; }
    PG8_BAR;
    if constexpr (Epi::AFTER_DRAIN) { E.fused(acc, cur, wr, wc, fr, fq, lds, wid, lane); S.done(cur); }
#undef PG8_SA
#undef PG8_SB
#undef PG8_STAGE
#undef PG8_LDA
#undef PG8_LDB
#undef PG8_MMA
#undef PG8_WAIT_V
#undef PG8_WAIT_L
#undef PG8_BAR
#undef PG8_SCHED
}
}
#define LAS __attribute__((address_space(3)))
typedef unsigned short bf16_t;
typedef short bf16x8 __attribute__((ext_vector_type(8)));
typedef short s16x4 __attribute__((ext_vector_type(4)));
typedef float f32x4 __attribute__((ext_vector_type(4)));
typedef float f32x16 __attribute__((ext_vector_type(16)));
typedef unsigned u32x4 __attribute__((ext_vector_type(4)));
typedef unsigned u32x2 __attribute__((ext_vector_type(2)));
constexpr int NB = 8, SEQ = 2048, DM = 1024, MR = NB * SEQ, NH = 8, HD = 64, AW = 512, INC = 2056, FF = 2816, FF2 = 5632, NL = 2;
constexpr float EPS = 1e-6f, LOG2E = 1.4426950408889634f, QSCALE = 0.125f * 1.4426950408889634f;
constexpr size_t MiB = 1u << 20;
constexpr size_t WS_PART = 1 * MiB;
constexpr size_t WS_LF = 4 * MiB;
constexpr size_t WS_W0 = 5 * MiB, WS_WL = 23 * MiB;
constexpr size_t WO_IN = 0, WO_OUT = 4 * MiB, WO_UP = 6 * MiB, WO_DN = 17 * MiB, WO_PW = 22 * MiB + 512 * 1024;
constexpr size_t WS_XN = 52 * MiB;
constexpr size_t WS_Q = 84 * MiB, WS_K = 100 * MiB, WS_V = 116 * MiB, WS_U = 132 * MiB, WS_MIX = 148 * MiB;
constexpr size_t WS_G = 84 * MiB;
constexpr size_t WS_RAW = 180 * MiB;
constexpr size_t WS_END = 202 * MiB;
constexpr int LDS_BYTES = 147456;

__device__ __forceinline__ unsigned pk_bf16(float lo, float hi) { unsigned r; asm volatile("v_cvt_pk_bf16_f32 %0, %1, %2" : "=v"(r) : "v"(lo), "v"(hi)); return r; }
__device__ __forceinline__ float bf_lo(unsigned w) { return __uint_as_float(w << 16); }
__device__ __forceinline__ float bf_hi(unsigned w) { return __uint_as_float(w & 0xffff0000u); }
__device__ __forceinline__ float wave_sum(float v) {
#pragma unroll
    for (int o = 1; o < 64; o <<= 1) v += __shfl_xor(v, o);
    return v;
}

struct Args { const float* x; const float* c; const float* mod_w; const float* mod_b; const float* n1g; const float* n2g; const float* w_in; const float* b_f;
              const float* pool_w; const float* pool_scale; const float* w_out; const float* ffn_up; const float* conv_w; const float* conv_b; const float* ffn_down;
              const float* final_g; float* out; unsigned char* ws; int ph_lo, ph_hi; };

__device__ __forceinline__ void transpose_item(const float* W, int ldn, int k0, int n0src, bf16_t* WT, int K, int dst0, LAS float* scr, int lane) {
#pragma unroll 8
    for (int i = 0; i < 32; ++i) { const int kk = 2 * i + (lane >> 5); scr[kk * 33 + (lane & 31)] = W[(size_t)(k0 + kk) * ldn + n0src + (lane & 31)]; }
    asm volatile("s_waitcnt lgkmcnt(0)" ::: "memory");
    const int c = lane & 7;
#pragma unroll
    for (int j = 0; j < 4; ++j) { const int n = (lane >> 3) + 8 * j; const LAS float* s = scr + (8 * c) * 33 + n;
        u32x4 o; o.x = pk_bf16(s[0 * 33], s[1 * 33]); o.y = pk_bf16(s[2 * 33], s[3 * 33]); o.z = pk_bf16(s[4 * 33], s[5 * 33]); o.w = pk_bf16(s[6 * 33], s[7 * 33]);
        *(u32x4*)(WT + (size_t)(dst0 + n) * K + k0 + 8 * c) = o; }
    asm volatile("s_waitcnt lgkmcnt(0)" ::: "memory");
}
__device__ __forceinline__ void prologue(const Args& a, LAS unsigned char* lds, int tid, int lane, int wave, int G) {
    LAS float* cact = (LAS float*)(lds + 73728);
    for (int i = tid; i < NB * DM; i += 512) { const int b = i >> 10, k = i & 1023; const float v = a.c[i]; cact[k * 8 + b] = v / (1.f + __expf(-v)); }
    __syncthreads();
    LAS float* scr = (LAS float*)(lds + wave * 8704);
    float* part = (float*)(a.ws + WS_PART);
    const int gw = wave * G + (int)blockIdx.x, NGW = G * 8;
    constexpr int I_MOD = NL * 24 * 8, I_IN = 16 * 64, I_OUT = 16 * 32, I_UP = 16 * 176, I_DN = 44 * 32, I_PW = 4 * 2 * 4, I_L = I_IN + I_OUT + I_UP + I_DN + I_PW;
    for (int it = gw; it < I_MOD + NL * I_L; it += NGW) {
        if (it < I_MOD) {
            const int l = it / 192, r = it % 192, cc = r >> 3, kc = r & 7;
            const float* Wm = a.mod_w + (size_t)l * DM * 6144 + (size_t)(kc * 128) * 6144 + cc * 256 + lane * 4;
            f32x4 acc[8];
#pragma unroll
            for (int b = 0; b < 8; ++b) acc[b] = (f32x4){0.f, 0.f, 0.f, 0.f};
#pragma unroll 8
            for (int kk = 0; kk < 128; ++kk) { const f32x4 w = *(const f32x4*)(Wm + (size_t)kk * 6144);
                const f32x4 c0 = *(const LAS f32x4*)(cact + (kc * 128 + kk) * 8), c1 = *(const LAS f32x4*)(cact + (kc * 128 + kk) * 8 + 4);
                acc[0] += w * c0[0]; acc[1] += w * c0[1]; acc[2] += w * c0[2]; acc[3] += w * c0[3]; acc[4] += w * c1[0]; acc[5] += w * c1[1]; acc[6] += w * c1[2]; acc[7] += w * c1[3]; }
            if (kc == 0) { const f32x4 bv = *(const f32x4*)(a.mod_b + l * 6144 + cc * 256 + lane * 4);
#pragma unroll
                for (int b = 0; b < 8; ++b) acc[b] += bv; }
#pragma unroll
            for (int b = 0; b < 8; ++b) *(f32x4*)(part + ((size_t)((kc * 2 + l) * 8 + b)) * 6144 + cc * 256 + lane * 4) = acc[b];
            continue;
        }
        int r = it - I_MOD; const int l = r / I_L; r -= l * I_L;
        unsigned char* wl = a.ws + WS_W0 + (size_t)l * WS_WL;
        if (r < I_IN) { const int kb = r / 64, nb = r % 64; const int src = nb < 48 ? 32 * nb : 1544 + 32 * (nb - 48);
            transpose_item(a.w_in + (size_t)l * DM * INC, INC, 64 * kb, src, (bf16_t*)(wl + WO_IN), DM, 32 * nb, scr, lane); continue; } r -= I_IN;
        if (r < I_OUT) { const int kb = r / 32, nb = r % 32;
            transpose_item(a.w_out + (size_t)l * DM * DM, DM, 64 * kb, 32 * nb, (bf16_t*)(wl + WO_OUT), DM, 32 * nb, scr, lane); continue; } r -= I_OUT;
        if (r < I_UP) { const int kb = r / 176, nb = r % 176, pn = nb >> 3, wi = nb & 7; const int src = wi < 4 ? 128 * pn + 32 * wi : FF + 128 * pn + 32 * (wi - 4);
            transpose_item(a.ffn_up + (size_t)l * DM * FF2, FF2, 64 * kb, src, (bf16_t*)(wl + WO_UP), DM, 32 * nb, scr, lane); continue; } r -= I_UP;
        if (r < I_DN) { const int kb = r / 32, nb = r % 32;
            transpose_item(a.ffn_down + (size_t)l * FF * DM, DM, 64 * kb, 32 * nb, (bf16_t*)(wl + WO_DN), FF, 32 * nb, scr, lane); continue; } r -= I_DN;
        { const int g = r >> 3, kb = (r >> 2) & 1, nb = r & 3;
            transpose_item(a.pool_w + (size_t)(l * 4 + g) * 128 * 128, 128, 64 * kb, 32 * nb, (bf16_t*)(wl + WO_PW) + (size_t)g * 128 * 128, 128, 32 * nb, scr, lane); }
    }
}

template <bool WITH_F>
__device__ __forceinline__ void norm_phase(const Args& a, const float* xin, int l, int whichb, const float* gvec, LAS unsigned char* lds, int tid, int lane, int wave, int G) {
    LAS float* gm_l = (LAS float*)lds; LAS float* sh_l = gm_l + 1024;
    const float* part = (const float*)(a.ws + WS_PART);
    bf16_t* XN = (bf16_t*)(a.ws + WS_XN);
    float* LF = (float*)(a.ws + WS_LF);
    f32x4 wf[WITH_F ? 16 : 1][2];
    if (WITH_F) {
        const float* wi = a.w_in + (size_t)l * DM * INC + 1536;
#pragma unroll
        for (int j = 0; j < 4; ++j)
#pragma unroll
            for (int e = 0; e < 4; ++e) { const int k = 4 * lane + 256 * j + e; wf[j * 4 + e][0] = *(const f32x4*)(wi + (size_t)k * INC); wf[j * 4 + e][1] = *(const f32x4*)(wi + (size_t)k * INC + 4); }
    }
    for (int blk = blockIdx.x; blk < MR / 64; blk += G) {
        const int b = blk >> 5;
        __syncthreads();
        for (int k = tid; k < DM; k += 512) { float sh = 0.f, sc = 0.f;
#pragma unroll
            for (int kc = 0; kc < 8; ++kc) { const float* p = part + ((size_t)((kc * 2 + l) * 8 + b)) * 6144 + k; sh += p[whichb * 1024]; sc += p[(whichb + 1) * 1024]; }
            gm_l[k] = gvec[k] * (1.f + sc); sh_l[k] = sh; }
        __syncthreads();
        f32x4 gm[4], sh[4];
#pragma unroll
        for (int j = 0; j < 4; ++j) { gm[j] = *(const LAS f32x4*)(gm_l + 4 * lane + 256 * j); sh[j] = *(const LAS f32x4*)(sh_l + 4 * lane + 256 * j); }
#pragma unroll 2
        for (int i = 0; i < 8; ++i) {
            const int row = blk * 64 + wave * 8 + i;
            const f32x4* xr = (const f32x4*)(xin + (size_t)row * DM) + lane;
            f32x4 v[4]; float s = 0.f;
#pragma unroll
            for (int j = 0; j < 4; ++j) { v[j] = xr[64 * j]; s += (v[j].x * v[j].x + v[j].y * v[j].y) + (v[j].z * v[j].z + v[j].w * v[j].w); }
            const float rstd = 1.f / sqrtf(wave_sum(s) * (1.f / DM) + EPS);
            unsigned long long* o8 = (unsigned long long*)(XN + (size_t)row * DM) + lane;
#pragma unroll
            for (int j = 0; j < 4; ++j) { v[j] = v[j] * rstd * gm[j] + sh[j];
                o8[64 * j] = (unsigned long long)pk_bf16(v[j].x, v[j].y) | ((unsigned long long)pk_bf16(v[j].z, v[j].w) << 32); }
            if (WITH_F) {
                f32x4 d0 = (f32x4){0.f, 0.f, 0.f, 0.f}, d1 = d0;
#pragma unroll
                for (int j = 0; j < 4; ++j)
#pragma unroll
                    for (int e = 0; e < 4; ++e) { d0 += wf[j * 4 + e][0] * v[j][e]; d1 += wf[j * 4 + e][1] * v[j][e]; }
                float dd[8] = {d0[0], d0[1], d0[2], d0[3], d1[0], d1[1], d1[2], d1[3]};
#pragma unroll
                for (int h = 0; h < 8; ++h) dd[h] = wave_sum(dd[h]);
                float mine = dd[0];
#pragma unroll
                for (int h = 1; h < 8; ++h) mine = (lane == h) ? dd[h] : mine;
                if (lane < 8) { const float z = mine + a.b_f[l * NH + lane]; const float lf = fminf(z, 0.f) - log1pf(__expf(-fabsf(z)));
                    LF[((size_t)(b * NH + lane)) * SEQ + (row & (SEQ - 1))] = lf; }
            }
        }
    }
}

__device__ __forceinline__ void final_norm(const Args& a, int lane, int wave, int G) {
    f32x4 g[4];
#pragma unroll
    for (int j = 0; j < 4; ++j) g[j] = *((const f32x4*)a.final_g + lane + 64 * j);
    for (int row = blockIdx.x * 8 + wave; row < MR; row += G * 8) {
        f32x4* xr = (f32x4*)(a.out + (size_t)row * DM) + lane;
        f32x4 v[4]; float s = 0.f;
#pragma unroll
        for (int j = 0; j < 4; ++j) { v[j] = xr[64 * j]; s += (v[j].x * v[j].x + v[j].y * v[j].y) + (v[j].z * v[j].z + v[j].w * v[j].w); }
        const float rstd = 1.f / sqrtf(wave_sum(s) * (1.f / DM) + EPS);
#pragma unroll
        for (int j = 0; j < 4; ++j) xr[64 * j] = v[j] * rstd * g[j];
    }
}

__device__ __forceinline__ int crow(int r, int hi) { return (r & 3) + 8 * (r >> 2) + 4 * hi; }
constexpr int AL_FS = 0, AL_WT = 8192, AL_K = 16384, AL_V = 32768;
__device__ __forceinline__ void attn_unit(const Args& a, int b, int h, int qb, LAS unsigned char* lds, int tid, int lane, int wave) {
    const bf16_t* Q = (const bf16_t*)(a.ws + WS_Q); const bf16_t* K = (const bf16_t*)(a.ws + WS_K); const bf16_t* V = (const bf16_t*)(a.ws + WS_V);
    bf16_t* MIX = (bf16_t*)(a.ws + WS_MIX);
    const float* LF = (const float*)(a.ws + WS_LF) + (size_t)(b * NH + h) * SEQ;
    LAS float* FS = (LAS float*)(lds + AL_FS); LAS float* WT = (LAS float*)(lds + AL_WT);
    const int r32 = lane & 31, hi = lane >> 5;
    const int NT = 4 * (qb + 1);
    __syncthreads();
    {
        const f32x4 v = *((const f32x4*)LF + tid);
        const float tot = (v.x + v.y) + (v.z + v.w); float inc = tot;
#pragma unroll
        for (int o = 1; o < 64; o <<= 1) { const float t = __shfl_up(inc, o); if (lane >= o) inc += t; }
        if (lane == 63) WT[wave] = inc;
        __syncthreads();
        float woff = 0.f;
        for (int w = 0; w < wave; ++w) woff += WT[w];
        const float ex = woff + inc - tot;
        f32x4 o; o.x = ex + v.x; o.y = o.x + v.y; o.z = o.y + v.z; o.w = o.z + v.w;
        *(LAS f32x4*)(FS + 4 * tid) = o * LOG2E;
    }
    const int skv = tid >> 3, sc = tid & 7;
    const size_t rowb = (size_t)b * SEQ;
    const bf16_t* kg = K + (rowb + skv) * AW + h * HD + sc * 8;
    const bf16_t* vg = V + (rowb + skv) * AW + h * HD + sc * 8;
    const int kst = skv * 128 + ((sc ^ ((skv >> 1) & 7)) * 16);
    const int vst = (sc >> 2) * 4096 + (skv >> 3) * 512 + (skv & 7) * 64 + (sc & 3) * 16;
    u32x4 kreg = *(const u32x4*)kg, vreg = *(const u32x4*)vg;
    const int q = qb * 256 + wave * 32 + r32;
    bf16x8 qr[4];
#pragma unroll
    for (int d0 = 0; d0 < 4; ++d0) qr[d0] = *(const bf16x8*)(Q + (rowb + q) * AW + h * HD + d0 * 16 + hi * 8);
    *(LAS u32x4*)(lds + AL_K + kst) = kreg; *(LAS u32x4*)(lds + AL_V + vst) = vreg;
    __syncthreads();
    const float FQ = FS[q];
    float mrun = -INFINITY, lsum = 0.f;
    f32x16 o0 = {}, o1 = {};
    const int qmax = qb * 256 + wave * 32 + 31;
    int koff[4];
#pragma unroll
    for (int d0 = 0; d0 < 4; ++d0) koff[d0] = r32 * 128 + (((2 * d0 + hi) ^ ((r32 >> 1) & 7)) * 16);
    const int voff = ((lane >> 4) & 1) * 32 + (lane & 3) * 8 + (4 * hi + ((lane & 15) >> 2)) * 64;
    for (int t = 0; t < NT; ++t) {
        const int cur = (t & 1) * 8192;
        if (t + 1 < NT) { kreg = *(const u32x4*)(kg + (size_t)(t + 1) * 64 * AW); vreg = *(const u32x4*)(vg + (size_t)(t + 1) * 64 * AW); }
        if (64 * t <= qmax) {
            const LAS unsigned char* Kb = lds + AL_K + cur; const LAS unsigned char* Vb = lds + AL_V + cur;
            f32x16 p0 = {}, p1 = {};
#pragma unroll
            for (int d0 = 0; d0 < 4; ++d0) {
                const bf16x8 k0 = *(const LAS bf16x8*)(Kb + koff[d0]); const bf16x8 k1 = *(const LAS bf16x8*)(Kb + koff[d0] + 32 * 128);
                p0 = __builtin_amdgcn_mfma_f32_32x32x16_bf16(k0, qr[d0], p0, 0, 0, 0);
                p1 = __builtin_amdgcn_mfma_f32_32x32x16_bf16(k1, qr[d0], p1, 0, 0, 0);
            }
            const int kv0 = 64 * t;
#pragma unroll
            for (int j = 0; j < 4; ++j) {
                const f32x4 f0 = *(const LAS f32x4*)(FS + kv0 + 4 * hi + 8 * j), f1 = *(const LAS f32x4*)(FS + kv0 + 32 + 4 * hi + 8 * j);
#pragma unroll
                for (int e = 0; e < 4; ++e) { p0[4 * j + e] += FQ - f0[e]; p1[4 * j + e] += FQ - f1[e]; }
            }
            if (kv0 + 63 > q - r32) {
#pragma unroll
                for (int r = 0; r < 16; ++r) { const int kv = kv0 + crow(r, hi); if (kv > q) p0[r] = -INFINITY; if (kv + 32 > q) p1[r] = -INFINITY; }
            }
            float rm = fmaxf(p0[0], p1[0]);
#pragma unroll
            for (int r = 1; r < 16; ++r) rm = fmaxf(rm, fmaxf(p0[r], p1[r]));
            rm = fmaxf(rm, __shfl_xor(rm, 32));
            const float mnew = fmaxf(mrun, rm);
            const float alpha = __builtin_amdgcn_exp2f(mrun - mnew);
            mrun = mnew;
            float ps = 0.f;
#pragma unroll
            for (int r = 0; r < 16; ++r) { p0[r] = __builtin_amdgcn_exp2f(p0[r] - mnew); p1[r] = __builtin_amdgcn_exp2f(p1[r] - mnew); ps += p0[r] + p1[r]; }
            lsum = lsum * alpha + ps;
#pragma unroll
            for (int r = 0; r < 16; ++r) { o0[r] *= alpha; o1[r] *= alpha; }
            u32x4 pw[4];
#pragma unroll
            for (int e = 0; e < 4; ++e) { pw[0][e] = pk_bf16(p0[2 * e], p0[2 * e + 1]); pw[1][e] = pk_bf16(p0[8 + 2 * e], p0[9 + 2 * e]);
                                          pw[2][e] = pk_bf16(p1[2 * e], p1[2 * e + 1]); pw[3][e] = pk_bf16(p1[8 + 2 * e], p1[9 + 2 * e]); }
#pragma unroll
            for (int ks = 0; ks < 4; ++ks) {
                const bf16x8 pf = __builtin_bit_cast(bf16x8, pw[ks]);
                typedef short v4i16_t __attribute__((ext_vector_type(4)));
                const s16x4 a0 = __builtin_bit_cast(s16x4, __builtin_amdgcn_ds_read_tr16_b64_v4i16((LAS v4i16_t*)(Vb + voff + ks * 1024)));
                const s16x4 a1 = __builtin_bit_cast(s16x4, __builtin_amdgcn_ds_read_tr16_b64_v4i16((LAS v4i16_t*)(Vb + voff + ks * 1024 + 512)));
                const s16x4 c0 = __builtin_bit_cast(s16x4, __builtin_amdgcn_ds_read_tr16_b64_v4i16((LAS v4i16_t*)(Vb + voff + 4096 + ks * 1024)));
                const s16x4 c1 = __builtin_bit_cast(s16x4, __builtin_amdgcn_ds_read_tr16_b64_v4i16((LAS v4i16_t*)(Vb + voff + 4096 + ks * 1024 + 512)));
                const bf16x8 v0 = (bf16x8){a0[0], a0[1], a0[2], a0[3], a1[0], a1[1], a1[2], a1[3]};
                const bf16x8 v1 = (bf16x8){c0[0], c0[1], c0[2], c0[3], c1[0], c1[1], c1[2], c1[3]};
                o0 = __builtin_amdgcn_mfma_f32_32x32x16_bf16(v0, pf, o0, 0, 0, 0);
                o1 = __builtin_amdgcn_mfma_f32_32x32x16_bf16(v1, pf, o1, 0, 0, 0);
            }
        }
        if (t + 1 < NT) { const int nxt = ((t + 1) & 1) * 8192; *(LAS u32x4*)(lds + AL_K + nxt + kst) = kreg; *(LAS u32x4*)(lds + AL_V + nxt + vst) = vreg; }
        __syncthreads();
    }
    lsum += __shfl_xor(lsum, 32);
    const float inv = 1.f / lsum;
    bf16_t* orow = MIX + (rowb + q) * DM + h * HD + 4 * hi;
#pragma unroll
    for (int j = 0; j < 4; ++j) {
        u32x2 w0, w1;
        w0.x = pk_bf16(o0[4 * j] * inv, o0[4 * j + 1] * inv); w0.y = pk_bf16(o0[4 * j + 2] * inv, o0[4 * j + 3] * inv);
        w1.x = pk_bf16(o1[4 * j] * inv, o1[4 * j + 1] * inv); w1.y = pk_bf16(o1[4 * j + 2] * inv, o1[4 * j + 3] * inv);
        *(u32x2*)(orow + 8 * j) = w0; *(u32x2*)(orow + 32 + 8 * j) = w1;
    }
}

__device__ __forceinline__ void pool_unit(const Args& a, int l, int rb, int g, int lane, int wave) {
    const bf16_t* U = (const bf16_t*)(a.ws + WS_U); bf16_t* MIX = (bf16_t*)(a.ws + WS_MIX);
    const bf16_t* PW = (const bf16_t*)(a.ws + WS_W0 + (size_t)l * WS_WL + WO_PW) + (size_t)g * 128 * 128;
    const int fr = lane & 15, fq = lane >> 4;
    const int row = rb * 128 + wave * 16 + fr, t = row & (SEQ - 1);
    const int w = 2 << g; const int cnt = (t + 1) < w ? (t + 1) : w; const float rc = 1.f / (float)cnt;
    bf16x8 af[4];
#pragma unroll
    for (int ks = 0; ks < 4; ++ks) {
        const bf16_t* up = U + (size_t)row * AW + 128 * g + 32 * ks + 8 * fq;
        float s[8];
        const u32x4 self = *(const u32x4*)up;
#pragma unroll
        for (int e = 0; e < 4; ++e) { s[2 * e] = bf_lo(self[e]); s[2 * e + 1] = bf_hi(self[e]); }
        for (int j = 1; j < w; ++j) { if (j < cnt) { const u32x4 v = *(const u32x4*)(up - (size_t)j * AW);
#pragma unroll
                for (int e = 0; e < 4; ++e) { s[2 * e] += bf_lo(v[e]); s[2 * e + 1] += bf_hi(v[e]); } } }
        u32x4 pk;
#pragma unroll
        for (int e = 0; e < 4; ++e) pk[e] = pk_bf16(s[2 * e] * rc - bf_lo(self[e]), s[2 * e + 1] * rc - bf_hi(self[e]));
        af[ks] = __builtin_bit_cast(bf16x8, pk);
    }
#pragma unroll
    for (int nt = 0; nt < 8; ++nt) {
        f32x4 acc = (f32x4){0.f, 0.f, 0.f, 0.f};
#pragma unroll
        for (int ks = 0; ks < 4; ++ks) { const bf16x8 bfr = *(const bf16x8*)(PW + (size_t)(16 * nt + fr) * 128 + 32 * ks + 8 * fq);
            acc = __builtin_amdgcn_mfma_f32_16x16x32_bf16(bfr, af[ks], acc, 0, 0, 0); }
        const int n0 = 128 * g + 16 * nt + 4 * fq;
        const f32x4 ps = *(const f32x4*)(a.pool_scale + l * 512 + n0);
        u32x2 o; o.x = pk_bf16(acc[0] * ps[0], acc[1] * ps[1]); o.y = pk_bf16(acc[2] * ps[2], acc[3] * ps[3]);
        *(u32x2*)(MIX + (size_t)row * DM + 512 + n0) = o;
    }
}

__device__ __forceinline__ void conv_fixup(const Args& a, int l, int pm, int tid) {
    const float* raw = (const float*)(a.ws + WS_RAW); bf16_t* Gb = (bf16_t*)(a.ws + WS_G);
    const float* cw = a.conv_w + (size_t)l * 3 * FF2; const float* cb = a.conv_b + (size_t)l * FF2;
    for (int i = tid; i < 4 * 2 * (FF / 4); i += 512) {
        const int c4 = i % (FF / 4), rr = (i / (FF / 4)) & 1, rg = i / (2 * (FF / 4));
        const int range = pm * 4 + rg, row = range * 64 + rr, ch = 4 * c4;
        const bool first = ((range * 64) & (SEQ - 1)) == 0;
        f32x4 cv[2];
#pragma unroll
        for (int bj = 0; bj < 2; ++bj) {
            const int c = bj * FF + ch;
            const f32x4 cur = *(const f32x4*)(raw + ((size_t)range * 4 + rr) * FF2 + c);
            f32x4 p1, p2; const f32x4 z = (f32x4){0.f, 0.f, 0.f, 0.f};
            if (rr == 0) { p1 = first ? z : *(const f32x4*)(raw + ((size_t)(range - 1) * 4 + 3) * FF2 + c); p2 = first ? z : *(const f32x4*)(raw + ((size_t)(range - 1) * 4 + 2) * FF2 + c); }
            else { p1 = *(const f32x4*)(raw + ((size_t)range * 4 + 0) * FF2 + c); p2 = first ? z : *(const f32x4*)(raw + ((size_t)(range - 1) * 4 + 3) * FF2 + c); }
            cv[bj] = *(const f32x4*)(cb + c) + *(const f32x4*)(cw + c) * p2 + *(const f32x4*)(cw + FF2 + c) * p1 + *(const f32x4*)(cw + 2 * FF2 + c) * cur;
        }
        f32x4 gg;
#pragma unroll
        for (int e = 0; e < 4; ++e) { const float x = cv[0][e]; gg[e] = x * __builtin_amdgcn_rcpf(1.f + __builtin_amdgcn_exp2f(-LOG2E * x)) * cv[1][e]; }
        u32x2 w; w.x = pk_bf16(gg[0], gg[1]); w.y = pk_bf16(gg[2], gg[3]);
        *(u32x2*)(Gb + (size_t)row * FF + ch) = w;
    }
}

#define XB_TMO      128
#define XB_XCNT(j)  (256  + 64 * (j))
#define XB_XSUB(j)  (1280 + 64 * (j))
#define XB_XGEN(j)  (2304 + 64 * (j))
#define XB_TOP      3328
#define XB_TOPGEN   3392
#define XCD_BAR_WORDS 3456
#define XB_SPIN_CAP (1u << 18)

__device__ __forceinline__ unsigned xb_ld(unsigned* p)              { return __hip_atomic_load(p, __ATOMIC_RELAXED, __HIP_MEMORY_SCOPE_AGENT); }
__device__ __forceinline__ unsigned xb_add(unsigned* p, unsigned v) { return __hip_atomic_fetch_add(p, v, __ATOMIC_RELAXED, __HIP_MEMORY_SCOPE_AGENT); }
__device__ __forceinline__ unsigned xb_xcc_id() { return (unsigned)__builtin_amdgcn_s_getreg((3 << 11) | 20) & 0xFu; }
#define XB_SPIN(cond, bar) do { unsigned _sp = 0; while (cond) { __builtin_amdgcn_s_sleep(1); \
    if ((++_sp & 255u) == 0u) { if (xb_ld(&(bar)[XB_TMO])) break; if (_sp > XB_SPIN_CAP) { atomicAdd(&(bar)[XB_TMO], 1u); break; } } } } while (0)

struct XcdBarrier {
    unsigned* bar; unsigned x;
    volatile LAS unsigned* st;
};

__device__ __forceinline__ XcdBarrier xcd_barrier_post(unsigned* bar, volatile LAS unsigned* st) {
    XcdBarrier b; b.bar = bar; b.x = xb_xcc_id(); b.st = st;
    if (threadIdx.x == 0) (void)xb_add(&bar[XB_XCNT(b.x)], 1u);
    return b;
}
__device__ __forceinline__ void xcd_barrier_complete(unsigned* bar, unsigned x, unsigned& nloc, unsigned& nx) {
    const unsigned G = gridDim.x * gridDim.y * gridDim.z;
    unsigned sum, cnt, mine, sp = 0u;
    for (;;) {
        sum = 0u; cnt = 0u; mine = 0u;
#pragma unroll
        for (unsigned j = 0; j < 16; ++j) { const unsigned c = xb_ld(&bar[XB_XCNT(j)]); sum += c; cnt += (c > 0u) ? 1u : 0u; mine = (j == x) ? c : mine; }
        if (sum == G) break;
        __builtin_amdgcn_s_sleep(1);
        if ((++sp & 255u) == 0u) { if (xb_ld(&bar[XB_TMO])) break; if (sp > XB_SPIN_CAP) { atomicAdd(&bar[XB_TMO], 1u); break; } }
    }
    nloc = mine > 0u ? mine : 1u; nx = cnt > 0u ? cnt : 1u;
}

__device__ __forceinline__ void xcd_barrier(const XcdBarrier& b) {
    asm volatile("s_waitcnt vmcnt(0)" ::: "memory");
    __syncthreads();
    if (threadIdx.x == 0) {
        unsigned* bar = b.bar;
        __builtin_amdgcn_s_waitcnt(0);
        unsigned nloc = b.st[0], nx = b.st[1];
        if (nloc == 0u) { xcd_barrier_complete(bar, b.x, nloc, nx); b.st[0] = nloc; b.st[1] = nx; }
        const unsigned old = xb_add(&bar[XB_XSUB(b.x)], 1u);
        const unsigned gen = old / nloc;
        if (old + 1u == (gen + 1u) * nloc) {
            __builtin_amdgcn_fence(__ATOMIC_RELEASE, "agent");
            asm volatile("s_waitcnt vmcnt(0)" ::: "memory");
            const unsigned og = xb_add(&bar[XB_TOP], 1u);
            const unsigned tg = og / nx;
            if (og + 1u == (tg + 1u) * nx) xb_add(&bar[XB_TOPGEN], 1u);
            else XB_SPIN(xb_ld(&bar[XB_TOPGEN]) == tg, bar);
            __builtin_amdgcn_fence(__ATOMIC_ACQUIRE, "agent");
            xb_add(&bar[XB_XGEN(b.x)], 1u);
            asm volatile("s_waitcnt vmcnt(0)" ::: "memory");
        } else {
            XB_SPIN(xb_ld(&bar[XB_XGEN(b.x)]) == gen, bar);
            __builtin_amdgcn_fence(__ATOMIC_ACQUIRE, "agent");
            asm volatile("s_waitcnt vmcnt(0)" ::: "memory");
        }
    }
    __syncthreads();
}

__global__ void __launch_bounds__(512, 2) fwd_kernel(Args a) {
    extern __shared__ __attribute__((aligned(16))) unsigned char lds_raw[];
    LAS unsigned char* lds = (LAS unsigned char*)lds_raw;
    cg::grid_group grid = cg::this_grid();
    { volatile LAS unsigned* st0 = (volatile LAS unsigned*)(lds + LDS_BYTES - 64); if (threadIdx.x < 2) st0[threadIdx.x] = 0u; __syncthreads(); }
    XcdBarrier bar = xcd_barrier_post((unsigned*)a.ws, (volatile LAS unsigned*)(lds + LDS_BYTES - 64));
    const int tid0 = threadIdx.x, G = gridDim.x;
    const int lo = a.ph_lo, hi = a.ph_hi;
    int ph = 0;
#define SEAM() do { if (lo <= ph && ph + 1 < hi) { if (ph == 0) grid.sync(); else xcd_barrier(bar); if ((DUP_MASK >> 10) & 1) xcd_barrier(bar); } ++ph; } while (0)
#define RUN() (lo <= ph && ph < hi)
#ifndef PH_MASK
#define PH_MASK 0x3ff
#endif
#define PHM(k) ((PH_MASK >> (k)) & 1)
#ifndef DUP_MASK
#define DUP_MASK 0
#endif
#define DUP(k) for (int rep_ = 0; rep_ < (((DUP_MASK >> (k)) & 1) ? 2 : 1); ++rep_)
#define FRESH() int tid = tid0, l = l0; asm volatile("" : "+v"(tid), "+s"(l)); const int lane = tid & 63, wave = __builtin_amdgcn_readfirstlane(tid >> 6); (void)lane; (void)wave;
    if (PHM(0) && RUN()) DUP(0) { const int l0 = 0; FRESH(); prologue(a, lds, tid, lane, wave, G); }
    SEAM();
    for (int l0 = 0; l0 < NL; ++l0) {
        if (PHM(1) && RUN()) DUP(1) { FRESH(); const float* xres = (l == 0) ? a.x : a.out; norm_phase<true>(a, xres, l, 0, a.n1g + l * DM, lds, tid, lane, wave, G); }
        SEAM();
        if (PHM(2) && RUN()) DUP(2) { FRESH(); unsigned char* wl = a.ws + WS_W0 + (size_t)l * WS_WL; pg8::Gemm g{(const bf16_t*)(a.ws + WS_XN), (const bf16_t*)(wl + WO_IN), MR, 2048, DM}; pg8::StaticOrder S; S.init(MR, 2048, G, (int)blockIdx.x);
            pg8::EpiBf16 E{(bf16_t*)(a.ws + WS_Q), AW, AW, (size_t)MR * AW, QSCALE};
            pg8::gemm_phase<pg8::EpiBf16, pg8::StaticOrder, true, true>(lds, g, S, E, tid); }
        SEAM();
        if (RUN()) DUP(3) { FRESH();
            if (PHM(3)) for (int p = blockIdx.x; p < NB * NH * 4; p += G) { const int bh = p >> 2, s = p & 3;
                attn_unit(a, bh >> 3, bh & 7, 7 - s, lds, tid, lane, wave);
                attn_unit(a, bh >> 3, bh & 7, s, lds, tid, lane, wave); }
            if (PHM(4)) for (int p = blockIdx.x; p < (MR / 128) * 4; p += G) pool_unit(a, l, p >> 2, p & 3, lane, wave);
        }
        SEAM();
        if (PHM(5) && RUN()) for (int rep_ = 0; rep_ < ((((DUP_MASK >> 5) & 1) && l0 == 0) ? 2 : 1); ++rep_) { FRESH(); unsigned char* wl = a.ws + WS_W0 + (size_t)l * WS_WL; const float* xres = (l == 0) ? a.x : a.out; pg8::Gemm g{(const bf16_t*)(a.ws + WS_MIX), (const bf16_t*)(wl + WO_OUT), MR, DM, DM}; pg8::StaticOrder S; S.init(MR, DM, G, (int)blockIdx.x);
            pg8::EpiRes E{xres, a.out, (const float*)(a.ws + WS_PART), l, 2};
            pg8::gemm_phase<pg8::EpiRes, pg8::StaticOrder, true, true>(lds, g, S, E, tid); }
        SEAM();
        if (PHM(6) && RUN()) DUP(6) { FRESH(); norm_phase<false>(a, a.out, l, 3, a.n2g + l * DM, lds, tid, lane, wave, G); }
        SEAM();
        if (PHM(7) && RUN()) DUP(7) { FRESH(); unsigned char* wl = a.ws + WS_W0 + (size_t)l * WS_WL; pg8::Gemm g{(const bf16_t*)(a.ws + WS_XN), (const bf16_t*)(wl + WO_UP), MR, FF2, DM}; pg8::StaticOrder S; S.init(MR, FF2, G, (int)blockIdx.x);
            pg8::EpiConv E{(bf16_t*)(a.ws + WS_G), (float*)(a.ws + WS_RAW), a.conv_w + (size_t)l * 3 * FF2, a.conv_b + (size_t)l * FF2};
            pg8::gemm_phase<pg8::EpiConv, pg8::StaticOrder, true, true>(lds, g, S, E, tid); }
        SEAM();
        if (PHM(8) && RUN()) { FRESH(); unsigned char* wl = a.ws + WS_W0 + (size_t)l * WS_WL; pg8::Gemm g{(const bf16_t*)(a.ws + WS_G), (const bf16_t*)(wl + WO_DN), MR, DM, FF}; pg8::StaticOrder S; S.init(MR, DM, G, (int)blockIdx.x);
            pg8::Unit u; for (int i = 0; S.next(i, u); ++i) conv_fixup(a, l, u.pm, tid);
            __threadfence(); __syncthreads();
            pg8::EpiRes E{a.out, a.out, (const float*)(a.ws + WS_PART), l, 5};
            pg8::gemm_phase<pg8::EpiRes, pg8::StaticOrder, true, true>(lds, g, S, E, tid); }
        SEAM();
    }
    if (PHM(9) && RUN()) { const int l0 = 0; FRESH(); final_norm(a, lane, wave, G); }
#undef SEAM
#undef RUN
}

#ifndef N_LAUNCH_MODE
#define N_LAUNCH_MODE 1
#endif
extern "C" void kernel_launch(void* const* d_in, const int* in_sizes, int n_in, void* d_out, int out_size, void* d_ws, size_t ws_size, hipStream_t stream) {
    static int grid = 0;
    if (grid == 0) {
        if (n_in != 16 || out_size != MR * DM || ws_size < WS_END) { fprintf(stderr, "kernel_launch: unexpected shapes (n_in %d out %d ws %zu)\n", n_in, out_size, ws_size); grid = -1; return; }
        int dev = 0, cus = 0, per_cu = 0;
        hipGetDevice(&dev); hipDeviceGetAttribute(&cus, hipDeviceAttributeMultiprocessorCount, dev);
        if (hipFuncSetAttribute((const void*)fwd_kernel, hipFuncAttributeMaxDynamicSharedMemorySize, LDS_BYTES) != hipSuccess) { fprintf(stderr, "kernel_launch: hipFuncSetAttribute failed\n"); grid = -1; return; }
        if (hipOccupancyMaxActiveBlocksPerMultiprocessor(&per_cu, (const void*)fwd_kernel, 512, LDS_BYTES) != hipSuccess || per_cu < 1) { fprintf(stderr, "kernel_launch: occupancy query says %d\n", per_cu); (void)hipGetLastError(); per_cu = 1; }
        grid = cus * 1;
        if (grid > cus * per_cu) grid = cus * per_cu;
    }
    if (grid < 0) return;
    if (hipMemsetAsync(d_ws, 0, 16384, stream) != hipSuccess) { fprintf(stderr, "kernel_launch: memset failed\n"); return; }
    Args a{};
    a.x = (const float*)d_in[0]; a.c = (const float*)d_in[1]; a.mod_w = (const float*)d_in[2]; a.mod_b = (const float*)d_in[3]; a.n1g = (const float*)d_in[4]; a.n2g = (const float*)d_in[5];
    a.w_in = (const float*)d_in[6]; a.b_f = (const float*)d_in[7]; a.pool_w = (const float*)d_in[8]; a.pool_scale = (const float*)d_in[9]; a.w_out = (const float*)d_in[10];
    a.ffn_up = (const float*)d_in[11]; a.conv_w = (const float*)d_in[12]; a.conv_b = (const float*)d_in[13]; a.ffn_down = (const float*)d_in[14]; a.final_g = (const float*)d_in[15];
    a.out = (float*)d_out; a.ws = (unsigned char*)d_ws;
    constexpr int NPH = 1 + 7 * NL + 1;
#if N_LAUNCH_MODE == 1
    a.ph_lo = 0; a.ph_hi = NPH;
    void* args[] = {&a};
    hipError_t e = hipLaunchCooperativeKernel((const void*)fwd_kernel, dim3(grid), dim3(512), args, LDS_BYTES, stream);
    if (e != hipSuccess) fprintf(stderr, "cooperative launch failed: %s (grid %d)\n", hipGetErrorString(e), grid);
#else
    for (int p = 0; p < NPH; ++p) { a.ph_lo = p; a.ph_hi = p + 1; hipLaunchKernelGGL(fwd_kernel, dim3(grid), dim3(512), LDS_BYTES, stream, a); }
#endif
}
```

```cpp
#include <hip/hip_runtime.h>
#include <hip/hip_cooperative_groups.h>
#include <cstdio>
#include <cstdint>
namespace cg = cooperative_groups;
namespace pg8 {
#define PG8_LAS __attribute__((address_space(3)))
typedef unsigned short bf16_t;
typedef short bf16x8 __attribute__((ext_vector_type(8)));
typedef float f32x4 __attribute__((ext_vector_type(4)));
typedef unsigned u32x4 __attribute__((ext_vector_type(4)));
constexpr int BM = 256, BK = 64, HALF = 128, HTB = HALF * BK * 2  , STAGE_BYTES = 8 * HTB, NXCD = 8, WGM = 8;

__host__ __device__ __forceinline__ int lds_byte(int r, int c) { const int st = (r >> 4) * 2 + (c >> 5), rr = r & 15, cc = c & 31, ob = rr * 64 + cc * 2; return st * 1024 + (ob ^ (((ob >> 9) & 1) << 5)); }
__host__ __device__ __forceinline__ void stage_rc(int b, int& R, int& C) { const int st = b / 1024, sb = b % 1024, swz = sb ^ (((sb >> 9) & 1) << 5); R = (st >> 1) * 16 + swz / 64; C = (st & 1) * 32 + (swz % 64) / 2; }
__host__ __device__ __forceinline__ int perm32(int rho) { const int n = rho >> 4, i = rho & 15; return 8 * (i >> 2) + 4 * n + (i & 3); }

struct Unit { int pm, pn; };
struct Gemm { const bf16_t* A; const bf16_t* Bt; int M, N, K; };

struct StaticOrder {
    int nM, nN, nwg, G, c;
    __host__ __device__ void init(int M, int N, int G_, int c_) { nM = M / BM; nN = N / BM; nwg = nM * nN; G = G_; c = c_; }
    __host__ __device__ bool next(int i, Unit& u) const {
        const long L = (long)i * G + c; if (L >= nwg) return false;
        int wgid = (int)L; { const int q = nwg / NXCD, r = nwg % NXCD, xcd = wgid % NXCD, off = wgid / NXCD; wgid = (xcd < r ? xcd * (q + 1) : r * (q + 1) + (xcd - r) * q) + off; }
        const int nig = WGM * nN, gid = wgid / nig, fm = gid * WGM, gsz = (nM - fm) < WGM ? (nM - fm) : WGM;
        u.pm = fm + ((wgid % nig) % gsz); u.pn = (wgid % nig) / gsz; return true;
    }
    __device__ __forceinline__ void a_ready(const Unit&) const {}
    __device__ __forceinline__ void done(const Unit&) const {}
};

__device__ __forceinline__ unsigned cvt_pk_bf16(float lo, float hi) { unsigned r; asm volatile("v_cvt_pk_bf16_f32 %0, %1, %2" : "=v"(r) : "v"(lo), "v"(hi)); return r; }
typedef unsigned u32x2 __attribute__((ext_vector_type(2)));
struct EpiBf16 {
    static constexpr bool PERM = true, AFTER_DRAIN = false;
    bf16_t* O; int ldc; int split_cols; size_t split_stride; float scale0;
    __device__ __forceinline__ void operator()(const f32x4 (&acc)[2][2][4][2], const Unit& u, int wr, int wc, int fr, int fq) const {
        const int row0 = u.pm * BM + wr * 64 + fr; int colt = u.pn * BM; bf16_t* base = O;
        float sc = 1.f; { const int t = colt / split_cols; base += (size_t)t * split_stride; colt -= t * split_cols; if (t == 0) sc = scale0; }
        const int col0 = colt + wc * 32 + 8 * fq;
#pragma unroll
        for (int ai = 0; ai < 2; ++ai)
#pragma unroll
            for (int m = 0; m < 4; ++m) { bf16_t* rowp = base + (size_t)(row0 + ai * HALF + m * 16) * ldc + col0;
#pragma unroll
                for (int bj = 0; bj < 2; ++bj) { f32x4 v0 = acc[ai][bj][m][0] * sc, v1 = acc[ai][bj][m][1] * sc;
                    u32x4 w; w.x = cvt_pk_bf16(v0[0], v0[1]); w.y = cvt_pk_bf16(v0[2], v0[3]); w.z = cvt_pk_bf16(v1[0], v1[1]); w.w = cvt_pk_bf16(v1[2], v1[3]);
                    *(u32x4*)(rowp + bj * HALF) = w; } }
    }
};
struct EpiRes {
    static constexpr bool PERM = false, AFTER_DRAIN = false;
    const float* base; float* out; const float* part; int l, which; float gscale;
    __device__ __forceinline__ void operator()(const f32x4 (&acc)[2][2][4][2], const Unit& u, int wr, int wc, int fr, int fq) const {
        const int b = u.pm >> 3; const int col0 = u.pn * BM + wc * 32 + 4 * fq;
        f32x4 gv[2][2];
#pragma unroll
        for (int bj = 0; bj < 2; ++bj)
#pragma unroll
            for (int n = 0; n < 2; ++n) { f32x4 s = (f32x4){0.f, 0.f, 0.f, 0.f};
#pragma unroll
                for (int kc = 0; kc < 8; ++kc) s += *(const f32x4*)(part + ((size_t)((kc * 2 + l) * 8 + b)) * 6144 + which * 1024 + col0 + bj * HALF + n * 16);
                gv[bj][n] = s * gscale; }
#pragma unroll
        for (int ai = 0; ai < 2; ++ai)
#pragma unroll
            for (int m = 0; m < 4; ++m) { const size_t off = (size_t)(u.pm * BM + ai * HALF + wr * 64 + m * 16 + fr) * 1024 + col0;
#pragma unroll
                for (int bj = 0; bj < 2; ++bj)
#pragma unroll
                    for (int n = 0; n < 2; ++n) { const f32x4 bs = *(const f32x4*)(base + off + bj * HALF + n * 16);
                        *(f32x4*)(out + off + bj * HALF + n * 16) = bs + gv[bj][n] * acc[ai][bj][m][n]; }
                if (m & 1) asm volatile("" ::: "memory"); }
    }
};
__device__ __forceinline__ float dpp_ror1(float v) { return __builtin_bit_cast(float, __builtin_amdgcn_mov_dpp(__builtin_bit_cast(int, v), 0x121, 0xf, 0xf, true)); }
__device__ __forceinline__ float dpp_ror2(float v) { return __builtin_bit_cast(float, __builtin_amdgcn_mov_dpp(__builtin_bit_cast(int, v), 0x122, 0xf, 0xf, true)); }
struct EpiConv {
    static constexpr bool PERM = true, AFTER_DRAIN = false;
    bf16_t* Gout; float* raw; const float* cw; const float* cb;
    __device__ __forceinline__ void operator()(const f32x4 (&acc)[2][2][4][2], const Unit& u, int wr, int wc, int fr, int fq) const {
        const int ch0 = u.pn * 128 + wc * 32 + 8 * fq;
#pragma unroll
        for (int n = 0; n < 2; ++n) {
            const int ch = ch0 + 4 * n;
            f32x4 w0[2], w1[2], w2[2], bb[2];
#pragma unroll
            for (int bj = 0; bj < 2; ++bj) { const int c = bj * 2816 + ch;
                w0[bj] = *(const f32x4*)(cw + c); w1[bj] = *(const f32x4*)(cw + 5632 + c); w2[bj] = *(const f32x4*)(cw + 2 * 5632 + c); bb[bj] = *(const f32x4*)(cb + c); }
#pragma unroll
            for (int ai = 0; ai < 2; ++ai)
#pragma unroll
                for (int m = 0; m < 4; ++m) {
                    const int row = u.pm * BM + ai * HALF + wr * 64 + m * 16 + fr;
                    f32x4 cv[2];
#pragma unroll
                    for (int bj = 0; bj < 2; ++bj) {
                        const f32x4 cur = acc[ai][bj][m][n]; const f32x4 prv = acc[ai][bj][m > 0 ? m - 1 : 0][n];
                        f32x4 p1, p2;
#pragma unroll
                        for (int e = 0; e < 4; ++e) { const float c1 = dpp_ror1(cur[e]), c2 = dpp_ror2(cur[e]), q1 = dpp_ror1(prv[e]), q2 = dpp_ror2(prv[e]);
                            p1[e] = fr >= 1 ? c1 : q1; p2[e] = fr >= 2 ? c2 : q2; }
                        cv[bj] = bb[bj] + w0[bj] * p2 + w1[bj] * p1 + w2[bj] * cur;
                        if (m == 0 && fr < 2) *(f32x4*)(raw + ((size_t)(row >> 6) * 4 + fr) * 5632 + bj * 2816 + ch) = cur;
                        if (m == 3 && fr >= 14) *(f32x4*)(raw + ((size_t)(row >> 6) * 4 + (fr - 12)) * 5632 + bj * 2816 + ch) = cur;
                    }
                    if (!(m == 0 && fr < 2)) {
                        f32x4 g;
#pragma unroll
                        for (int e = 0; e < 4; ++e) { const float x = cv[0][e]; g[e] = x * __builtin_amdgcn_rcpf(1.f + __builtin_amdgcn_exp2f(-1.4426950408889634f * x)) * cv[1][e]; }
                        u32x2 w; w.x = cvt_pk_bf16(g[0], g[1]); w.y = cvt_pk_bf16(g[2], g[3]);
                        *(u32x2*)(Gout + (size_t)row * 2816 + ch) = w;
                    }
                }
        }
    }
};
template <class Epi, class Sched, bool ALIGN_EPI = false, bool SP2 = false>
__device__ __forceinline__ void gemm_phase(PG8_LAS unsigned char* lds, const Gemm g, const Sched& S, const Epi& E, const int tid) {
    const int wid = __builtin_amdgcn_readfirstlane(tid >> 6), lane = tid & 63, wr = wid >> 2, wc = wid & 3, fr = lane & 15, fq = lane >> 4;
    const int K = g.K, nt = K / BK;
    unsigned voffA[2], voffB[2];
#pragma unroll
    for (int i = 0; i < 2; ++i) { int R, C; stage_rc(tid * 16 + i * 8192, R, C); const int Rb = Epi::PERM ? ((R & ~31) + perm32(R & 31)) : R;
        voffA[i] = (unsigned)(R * K + C) * 2u; voffB[i] = (unsigned)(Rb * K + C) * 2u; }
    const size_t kstep = (size_t)(BK * 2);
    const size_t hstep = (size_t)HALF * K * 2;
    const size_t tstep = 2 * hstep;
    const unsigned ldsw = (unsigned)wid * 1024u;
    const int aoff = lds_byte(wr * 64 + fr, fq * 8), boff = lds_byte(wc * 32 + fr, fq * 8);
#define PG8_SA(b, h) (((b) * 2 + (h)) * HTB)
#define PG8_SB(b, h) ((4 + (b) * 2 + (h)) * HTB)
#define PG8_STAGE(bufoff, gbase, voff) do { _Pragma("unroll") for (int _i = 0; _i < 2; ++_i) \
        __builtin_amdgcn_global_load_lds((const unsigned*)((const char*)(gbase) + (voff)[_i]), (PG8_LAS unsigned*)(lds + (bufoff) + ldsw + _i * 8192), 16, 0, 0); } while (0)
#define PG8_LDA(dst, b, h) do { _Pragma("unroll") for (int m = 0; m < 4; ++m) _Pragma("unroll") for (int k = 0; k < 2; ++k) dst[m][k] = *(const PG8_LAS bf16x8*)(lds + PG8_SA(b, h) + aoff + m * 2048 + k * 1024); } while (0)
#define PG8_LDB(dst, b, h) do { _Pragma("unroll") for (int n = 0; n < 2; ++n) _Pragma("unroll") for (int k = 0; k < 2; ++k) dst[n][k] = *(const PG8_LAS bf16x8*)(lds + PG8_SB(b, h) + boff + n * 2048 + k * 1024); } while (0)
#define PG8_MMA(ai, bj, At, Bt) do { __builtin_amdgcn_s_setprio(1); _Pragma("unroll") for (int m = 0; m < 4; ++m) _Pragma("unroll") for (int n = 0; n < 2; ++n) _Pragma("unroll") for (int k = 0; k < 2; ++k) \
        acc[ai][bj][m][n] = __builtin_amdgcn_mfma_f32_16x16x32_bf16(Bt[n][k], At[m][k], acc[ai][bj][m][n], 0, 0, 0); __builtin_amdgcn_s_setprio(0); } while (0)
#define PG8_WAIT_V(n) asm volatile("s_waitcnt vmcnt(" #n ")" ::: "memory")
#define PG8_WAIT_L(n) asm volatile("s_waitcnt lgkmcnt(" #n ")" ::: "memory")
#define PG8_BAR __builtin_amdgcn_s_barrier()
#define PG8_SCHED __builtin_amdgcn_sched_barrier(0)
    Unit cur, nxt; int ui = 0;
    if (!S.next(0, cur)) return;
    f32x4 acc[2][2][4][2];
#pragma unroll
    for (int a = 0; a < 2; ++a)
#pragma unroll
        for (int b = 0; b < 2; ++b)
#pragma unroll
            for (int m = 0; m < 4; ++m)
#pragma unroll
                for (int n = 0; n < 2; ++n) acc[a][b][m][n] = (f32x4){0.f, 0.f, 0.f, 0.f};
    bf16x8 At[4][2], B0[2][2], B1[2][2];
    const char* cA = (const char*)g.A + (size_t)cur.pm * tstep; const char* cB = (const char*)g.Bt + (size_t)cur.pn * tstep;
    S.a_ready(cur);
    if constexpr (SP2) {
        PG8_STAGE(PG8_SB(0, 0), cB, voffB); PG8_STAGE(PG8_SB(0, 1), cB + hstep, voffB); PG8_STAGE(PG8_SA(0, 0), cA, voffA); PG8_STAGE(PG8_SA(0, 1), cA + hstep, voffA);
        if (wr == 1) PG8_BAR;
        PG8_WAIT_V(2); PG8_BAR;
        PG8_STAGE(PG8_SB(1, 0), cB + kstep, voffB); PG8_STAGE(PG8_SA(1, 0), cA + kstep, voffA); PG8_STAGE(PG8_SB(1, 1), cB + hstep + kstep, voffB);
        PG8_WAIT_V(6); PG8_BAR;
    } else {
        PG8_STAGE(PG8_SB(0, 0), cB, voffB); PG8_STAGE(PG8_SA(0, 0), cA, voffA); PG8_STAGE(PG8_SB(0, 1), cB + hstep, voffB); PG8_STAGE(PG8_SA(0, 1), cA + hstep, voffA);
        if (wr == 1) PG8_BAR;
        PG8_WAIT_V(4); PG8_BAR;
        PG8_STAGE(PG8_SB(1, 0), cB + kstep, voffB); PG8_STAGE(PG8_SA(1, 0), cA + kstep, voffA); PG8_STAGE(PG8_SB(1, 1), cB + hstep + kstep, voffB);
        PG8_WAIT_V(6); PG8_BAR;
    }
    for (;;) {
        const bool has_next = S.next(ui + 1, nxt);
        const char* nA = has_next ? (const char*)g.A + (size_t)nxt.pm * tstep : cA; const char* nB = has_next ? (const char*)g.Bt + (size_t)nxt.pn * tstep : cB;
        for (int t = 0; t < nt; t += 2) {
            const bool last = (t == nt - 2);
            const char* a1 = cA + (size_t)(t + 1) * kstep;
            const char* a2 = last ? nA : cA + (size_t)(t + 2) * kstep; const char* b2 = last ? nB : cB + (size_t)(t + 2) * kstep;
            const char* a3 = a2 + kstep; const char* b3 = b2 + kstep;
            if (last && has_next) S.a_ready(nxt);
            if constexpr (SP2) {
            PG8_LDB(B0, 0, 0); PG8_LDB(B1, 0, 1); PG8_SCHED; PG8_LDA(At, 0, 0); PG8_STAGE(PG8_SA(1, 1), a1 + hstep, voffA);
            PG8_WAIT_V(8); PG8_WAIT_L(0); PG8_BAR; PG8_MMA(0, 0, At, B0); PG8_MMA(0, 1, At, B1); PG8_BAR; PG8_SCHED;
            PG8_LDA(At, 0, 1); PG8_STAGE(PG8_SB(0, 0), b2, voffB); PG8_STAGE(PG8_SB(0, 1), b2 + hstep, voffB); PG8_STAGE(PG8_SA(0, 0), a2, voffA);
            PG8_WAIT_V(8); PG8_WAIT_L(0); PG8_BAR; PG8_MMA(1, 0, At, B0); PG8_MMA(1, 1, At, B1); PG8_BAR; PG8_SCHED;
            PG8_LDB(B0, 1, 0); PG8_LDB(B1, 1, 1); PG8_SCHED; PG8_LDA(At, 1, 0); PG8_STAGE(PG8_SA(0, 1), a2 + hstep, voffA);
            PG8_WAIT_V(8); PG8_WAIT_L(0); PG8_BAR; PG8_MMA(0, 0, At, B0); PG8_MMA(0, 1, At, B1); PG8_BAR; PG8_SCHED;
            PG8_LDA(At, 1, 1); PG8_STAGE(PG8_SB(1, 0), b3, voffB); PG8_STAGE(PG8_SB(1, 1), b3 + hstep, voffB); PG8_STAGE(PG8_SA(1, 0), a3, voffA);
            PG8_WAIT_V(8); PG8_WAIT_L(0); PG8_BAR; PG8_MMA(1, 0, At, B0); PG8_MMA(1, 1, At, B1); PG8_BAR; PG8_SCHED;
            } else {
            PG8_LDB(B0, 0, 0); PG8_SCHED; PG8_LDA(At, 0, 0); PG8_STAGE(PG8_SA(1, 1), a1 + hstep, voffA);
            PG8_WAIT_L(8); PG8_BAR; PG8_WAIT_L(0); PG8_MMA(0, 0, At, B0); PG8_BAR; PG8_SCHED;
            PG8_LDB(B1, 0, 1); PG8_STAGE(PG8_SB(0, 0), b2, voffB);
            PG8_BAR; PG8_WAIT_L(0); PG8_MMA(0, 1, At, B1); PG8_BAR;
            PG8_LDA(At, 0, 1); PG8_STAGE(PG8_SA(0, 0), a2, voffA);
            PG8_BAR; PG8_WAIT_L(0); PG8_MMA(1, 0, At, B0); PG8_BAR; PG8_SCHED;
            PG8_STAGE(PG8_SB(0, 1), b2 + hstep, voffB);
            PG8_WAIT_V(6); PG8_BAR; PG8_MMA(1, 1, At, B1); PG8_BAR;
            PG8_LDB(B0, 1, 0); PG8_SCHED; PG8_LDA(At, 1, 0); PG8_STAGE(PG8_SA(0, 1), a2 + hstep, voffA);
            PG8_WAIT_L(8); PG8_BAR; PG8_WAIT_L(0); PG8_MMA(0, 0, At, B0); PG8_BAR; PG8_SCHED;
            PG8_LDB(B1, 1, 1); PG8_STAGE(PG8_SB(1, 0), b3, voffB);
            PG8_BAR; PG8_WAIT_L(0); PG8_MMA(0, 1, At, B1); PG8_BAR;
            PG8_LDA(At, 1, 1); PG8_STAGE(PG8_SA(1, 0), a3, voffA);
            PG8_BAR; PG8_WAIT_L(0); PG8_MMA(1, 0, At, B0); PG8_BAR; PG8_SCHED;
            PG8_STAGE(PG8_SB(1, 1), b3 + hstep, voffB);
            PG8_WAIT_V(6); PG8_BAR; PG8_MMA(1, 1, At, B1); PG8_BAR;
            }
        }
        if constexpr (ALIGN_EPI) { if (wr == 0) PG8_BAR; }
        if constexpr (!Epi::AFTER_DRAIN) { E(acc, cur, wr, wc, fr, fq); S.done(cur); }
        if (!has_next) break;
#pragma unroll
        for (int a = 0; a < 2; ++a)
#pragma unroll
            for (int b = 0; b < 2; ++b)
#pragma unroll
                for (int m = 0; m < 4; ++m)
#pragma unroll
                    for (int n = 0; n < 2; ++n) acc[a][b][m][n] = (f32x4){0.f, 0.f, 0.f, 0.f};
        cur = nxt; cA = nA; cB = nB; ++ui;
        if constexpr (ALIGN_EPI) { if (wr == 1) PG8_BAR; }
    }
    PG8_WAIT_V(0);
    if constexpr (!ALIGN_EPI) { if (wr == 0) PG8_BAR; }
    PG8_BAR;
    if constexpr (Epi::AFTER_DRAIN) { E.fused(acc, cur, wr, wc, fr, fq, lds, wid, lane); S.done(cur); }
#undef PG8_SA
#undef PG8_SB
#undef PG8_STAGE
#undef PG8_LDA
#undef PG8_LDB
#undef PG8_MMA
#undef PG8_WAIT_V
#undef PG8_WAIT_L
#undef PG8_BAR
#undef PG8_SCHED
}
}
#define LAS __attribute__((address_space(3)))
typedef unsigned short bf16_t;
typedef short bf16x8 __attribute__((ext_vector_type(8)));
typedef short s16x4 __attribute__((ext_vector_type(4)));
typedef float f32x4 __attribute__((ext_vector_type(4)));
typedef float f32x16 __attribute__((ext_vector_type(16)));
typedef unsigned u32x4 __attribute__((ext_vector_type(4)));
typedef unsigned u32x2 __attribute__((ext_vector_type(2)));
constexpr int NB = 8, SEQ = 2048, DM = 1024, MR = NB * SEQ, NH = 8, HD = 64, AW = 512, INC = 2056, FF = 2816, FF2 = 5632, NL = 2;
constexpr float EPS = 1e-6f, LOG2E = 1.4426950408889634f, QSCALE = 0.125f * 1.4426950408889634f;
constexpr size_t MiB = 1u << 20;
constexpr size_t WS_PART = 1 * MiB;
constexpr size_t WS_LF = 4 * MiB;
constexpr size_t WS_W0 = 5 * MiB, WS_WL = 23 * MiB;
constexpr size_t WO_IN = 0, WO_OUT = 4 * MiB, WO_UP = 6 * MiB, WO_DN = 17 * MiB, WO_PW = 22 * MiB + 512 * 1024;
constexpr size_t WS_XN = 52 * MiB;
constexpr size_t WS_Q = 84 * MiB, WS_K = 100 * MiB, WS_V = 116 * MiB, WS_U = 132 * MiB, WS_MIX = 148 * MiB;
constexpr size_t WS_G = 84 * MiB;
constexpr size_t WS_RAW = 180 * MiB;
constexpr size_t WS_END = 202 * MiB;
constexpr int LDS_BYTES = 147456;

__device__ __forceinline__ unsigned pk_bf16(float lo, float hi) { unsigned r; asm volatile("v_cvt_pk_bf16_f32 %0, %1, %2" : "=v"(r) : "v"(lo), "v"(hi)); return r; }
__device__ __forceinline__ float bf_lo(unsigned w) { return __uint_as_float(w << 16); }
__device__ __forceinline__ float bf_hi(unsigned w) { return __uint_as_float(w & 0xffff0000u); }
__device__ __forceinline__ float wave_sum(float v) {
#pragma unroll
    for (int o = 1; o < 64; o <<= 1) v += __shfl_xor(v, o);
    return v;
}

struct Args { const float* x; const float* c; const float* mod_w; const float* mod_b; const float* n1g; const float* n2g; const float* w_in; const float* b_f;
              const float* pool_w; const float* pool_scale; const float* w_out; const float* ffn_up; const float* conv_w; const float* conv_b; const float* ffn_down;
              const float* final_g; float* out; unsigned char* ws; int ph_lo, ph_hi; };

__device__ __forceinline__ void transpose_item(const float* W, int ldn, int k0, int n0src, bf16_t* WT, int K, int dst0, LAS float* scr, int lane) {
#pragma unroll 8
    for (int i = 0; i < 32; ++i) { const int kk = 2 * i + (lane >> 5); scr[kk * 33 + (lane & 31)] = W[(size_t)(k0 + kk) * ldn + n0src + (lane & 31)]; }
    asm volatile("s_waitcnt lgkmcnt(0)" ::: "memory");
    const int c = lane & 7;
#pragma unroll
    for (int j = 0; j < 4; ++j) { const int n = (lane >> 3) + 8 * j; const LAS float* s = scr + (8 * c) * 33 + n;
        u32x4 o; o.x = pk_bf16(s[0 * 33], s[1 * 33]); o.y = pk_bf16(s[2 * 33], s[3 * 33]); o.z = pk_bf16(s[4 * 33], s[5 * 33]); o.w = pk_bf16(s[6 * 33], s[7 * 33]);
        *(u32x4*)(WT + (size_t)(dst0 + n) * K + k0 + 8 * c) = o; }
    asm volatile("s_waitcnt lgkmcnt(0)" ::: "memory");
}
__device__ __forceinline__ void prologue(const Args& a, LAS unsigned char* lds, int tid, int lane, int wave, int G) {
    LAS float* cact = (LAS float*)(lds + 73728);
    for (int i = tid; i < NB * DM; i += 512) { const int b = i >> 10, k = i & 1023; const float v = a.c[i]; cact[k * 8 + b] = v / (1.f + __expf(-v)); }
    __syncthreads();
    LAS float* scr = (LAS float*)(lds + wave * 8704);
    float* part = (float*)(a.ws + WS_PART);
    const int gw = wave * G + (int)blockIdx.x, NGW = G * 8;
    constexpr int I_MOD = NL * 24 * 8, I_IN = 16 * 64, I_OUT = 16 * 32, I_UP = 16 * 176, I_DN = 44 * 32, I_PW = 4 * 2 * 4, I_L = I_IN + I_OUT + I_UP + I_DN + I_PW;
    for (int it = gw; it < I_MOD + NL * I_L; it += NGW) {
        if (it < I_MOD) {
            const int l = it / 192, r = it % 192, cc = r >> 3, kc = r & 7;
            const float* Wm = a.mod_w + (size_t)l * DM * 6144 + (size_t)(kc * 128) * 6144 + cc * 256 + lane * 4;
            f32x4 acc[8];
#pragma unroll
            for (int b = 0; b < 8; ++b) acc[b] = (f32x4){0.f, 0.f, 0.f, 0.f};
#pragma unroll 8
            for (int kk = 0; kk < 128; ++kk) { const f32x4 w = *(const f32x4*)(Wm + (size_t)kk * 6144);
                const f32x4 c0 = *(const LAS f32x4*)(cact + (kc * 128 + kk) * 8), c1 = *(const LAS f32x4*)(cact + (kc * 128 + kk) * 8 + 4);
                acc[0] += w * c0[0]; acc[1] += w * c0[1]; acc[2] += w * c0[2]; acc[3] += w * c0[3]; acc[4] += w * c1[0]; acc[5] += w * c1[1]; acc[6] += w * c1[2]; acc[7] += w * c1[3]; }
            if (kc == 0) { const f32x4 bv = *(const f32x4*)(a.mod_b + l * 6144 + cc * 256 + lane * 4);
#pragma unroll
                for (int b = 0; b < 8; ++b) acc[b] += bv; }
#pragma unroll
            for (int b = 0; b < 8; ++b) *(f32x4*)(part + ((size_t)((kc * 2 + l) * 8 + b)) * 6144 + cc * 256 + lane * 4) = acc[b];
            continue;
        }
        int r = it - I_MOD; const int l = r / I_L; r -= l * I_L;
        unsigned char* wl = a.ws + WS_W0 + (size_t)l * WS_WL;
        if (r < I_IN) { const int kb = r / 64, nb = r % 64; const int src = nb < 48 ? 32 * nb : 1544 + 32 * (nb - 48);
            transpose_item(a.w_in + (size_t)l * DM * INC, INC, 64 * kb, src, (bf16_t*)(wl + WO_IN), DM, 32 * nb, scr, lane); continue; } r -= I_IN;
        if (r < I_OUT) { const int kb = r / 32, nb = r % 32;
            transpose_item(a.w_out + (size_t)l * DM * DM, DM, 64 * kb, 32 * nb, (bf16_t*)(wl + WO_OUT), DM, 32 * nb, scr, lane); continue; } r -= I_OUT;
        if (r < I_UP) { const int kb = r / 176, nb = r % 176, pn = nb >> 3, wi = nb & 7; const int src = wi < 4 ? 128 * pn + 32 * wi : FF + 128 * pn + 32 * (wi - 4);
            transpose_item(a.ffn_up + (size_t)l * DM * FF2, FF2, 64 * kb, src, (bf16_t*)(wl + WO_UP), DM, 32 * nb, scr, lane); continue; } r -= I_UP;
        if (r < I_DN) { const int kb = r / 32, nb = r % 32;
            transpose_item(a.ffn_down + (size_t)l * FF * DM, DM, 64 * kb, 32 * nb, (bf16_t*)(wl + WO_DN), FF, 32 * nb, scr, lane); continue; } r -= I_DN;
        { const int g = r >> 3, kb = (r >> 2) & 1, nb = r & 3;
            transpose_item(a.pool_w + (size_t)(l * 4 + g) * 128 * 128, 128, 64 * kb, 32 * nb, (bf16_t*)(wl + WO_PW) + (size_t)g * 128 * 128, 128, 32 * nb, scr, lane); }
    }
}

template <bool WITH_F>
__device__ __forceinline__ void norm_phase(const Args& a, const float* xin, int l, int whichb, const float* gvec, LAS unsigned char* lds, int tid, int lane, int wave, int G) {
    LAS float* gm_l = (LAS float*)lds; LAS float* sh_l = gm_l + 1024;
    const float* part = (const float*)(a.ws + WS_PART);
    bf16_t* XN = (bf16_t*)(a.ws + WS_XN);
    float* LF = (float*)(a.ws + WS_LF);
    f32x4 wf[WITH_F ? 16 : 1][2];
    if (WITH_F) {
        const float* wi = a.w_in + (size_t)l * DM * INC + 1536;
#pragma unroll
        for (int j = 0; j < 4; ++j)
#pragma unroll
            for (int e = 0; e < 4; ++e) { const int k = 4 * lane + 256 * j + e; wf[j * 4 + e][0] = *(const f32x4*)(wi + (size_t)k * INC); wf[j * 4 + e][1] = *(const f32x4*)(wi + (size_t)k * INC + 4); }
    }
    for (int blk = blockIdx.x; blk < MR / 64; blk += G) {
        const int b = blk >> 5;
        __syncthreads();
        for (int k = tid; k < DM; k += 512) { float sh = 0.f, sc = 0.f;
#pragma unroll
            for (int kc = 0; kc < 8; ++kc) { const float* p = part + ((size_t)((kc * 2 + l) * 8 + b)) * 6144 + k; sh += p[whichb * 1024]; sc += p[(whichb + 1) * 1024]; }
            gm_l[k] = gvec[k] * (1.f + sc); sh_l[k] = sh; }
        __syncthreads();
        f32x4 gm[4], sh[4];
#pragma unroll
        for (int j = 0; j < 4; ++j) { gm[j] = *(const LAS f32x4*)(gm_l + 4 * lane + 256 * j); sh[j] = *(const LAS f32x4*)(sh_l + 4 * lane + 256 * j); }
#pragma unroll 2
        for (int i = 0; i < 8; ++i) {
            const int row = blk * 64 + wave * 8 + i;
            const f32x4* xr = (const f32x4*)(xin + (size_t)row * DM) + lane;
            f32x4 v[4]; float s = 0.f;
#pragma unroll
            for (int j = 0; j < 4; ++j) { v[j] = xr[64 * j]; s += (v[j].x * v[j].x + v[j].y * v[j].y) + (v[j].z * v[j].z + v[j].w * v[j].w); }
            const float rstd = 1.f / sqrtf(wave_sum(s) * (1.f / DM) + EPS);
            unsigned long long* o8 = (unsigned long long*)(XN + (size_t)row * DM) + lane;
#pragma unroll
            for (int j = 0; j < 4; ++j) { v[j] = v[j] * rstd * gm[j] + sh[j];
                o8[64 * j] = (unsigned long long)pk_bf16(v[j].x, v[j].y) | ((unsigned long long)pk_bf16(v[j].z, v[j].w) << 32); }
            if (WITH_F) {
                f32x4 d0 = (f32x4){0.f, 0.f, 0.f, 0.f}, d1 = d0;
#pragma unroll
                for (int j = 0; j < 4; ++j)
#pragma unroll
                    for (int e = 0; e < 4; ++e) { d0 += wf[j * 4 + e][0] * v[j][e]; d1 += wf[j * 4 + e][1] * v[j][e]; }
                float dd[8] = {d0[0], d0[1], d0[2], d0[3], d1[0], d1[1], d1[2], d1[3]};
#pragma unroll
                for (int h = 0; h < 8; ++h) dd[h] = wave_sum(dd[h]);
                float mine = dd[0];
#pragma unroll
                for (int h = 1; h < 8; ++h) mine = (lane == h) ? dd[h] : mine;
                if (lane < 8) { const float z = mine + a.b_f[l * NH + lane]; const float lf = fminf(z, 0.f) - log1pf(__expf(-fabsf(z)));
                    LF[((size_t)(b * NH + lane)) * SEQ + (row & (SEQ - 1))] = lf; }
            }
        }
    }
}

__device__ __forceinline__ void final_norm(const Args& a, int lane, int wave, int G) {
    f32x4 g[4];
#pragma unroll
    for (int j = 0; j < 4; ++j) g[j] = *((const f32x4*)a.final_g + lane + 64 * j);
    for (int row = blockIdx.x * 8 + wave; row < MR; row += G * 8) {
        f32x4* xr = (f32x4*)(a.out + (size_t)row * DM) + lane;
        f32x4 v[4]; float s = 0.f;
#pragma unroll
        for (int j = 0; j < 4; ++j) { v[j] = xr[64 * j]; s += (v[j].x * v[j].x + v[j].y * v[j].y) + (v[j].z * v[j].z + v[j].w * v[j].w); }
        const float rstd = 1.f / sqrtf(wave_sum(s) * (1.f / DM) + EPS);
#pragma unroll
        for (int j = 0; j < 4; ++j) xr[64 * j] = v[j] * rstd * g[j];
    }
}

__device__ __forceinline__ int crow(int r, int hi) { return (r & 3) + 8 * (r >> 2) + 4 * hi; }
constexpr int AL_FS = 0, AL_WT = 8192, AL_K = 16384, AL_V = 32768;
__device__ __forceinline__ void attn_unit(const Args& a, int b, int h, int qb, LAS unsigned char* lds, int tid, int lane, int wave) {
    const bf16_t* Q = (const bf16_t*)(a.ws + WS_Q); const bf16_t* K = (const bf16_t*)(a.ws + WS_K); const bf16_t* V = (const bf16_t*)(a.ws + WS_V);
    bf16_t* MIX = (bf16_t*)(a.ws + WS_MIX);
    const float* LF = (const float*)(a.ws + WS_LF) + (size_t)(b * NH + h) * SEQ;
    LAS float* FS = (LAS float*)(lds + AL_FS); LAS float* WT = (LAS float*)(lds + AL_WT);
    const int r32 = lane & 31, hi = lane >> 5;
    const int NT = 4 * (qb + 1);
    __syncthreads();
    {
        const f32x4 v = *((const f32x4*)LF + tid);
        const float tot = (v.x + v.y) + (v.z + v.w); float inc = tot;
#pragma unroll
        for (int o = 1; o < 64; o <<= 1) { const float t = __shfl_up(inc, o); if (lane >= o) inc += t; }
        if (lane == 63) WT[wave] = inc;
        __syncthreads();
        float woff = 0.f;
        for (int w = 0; w < wave; ++w) woff += WT[w];
        const float ex = woff + inc - tot;
        f32x4 o; o.x = ex + v.x; o.y = o.x + v.y; o.z = o.y + v.z; o.w = o.z + v.w;
        *(LAS f32x4*)(FS + 4 * tid) = o * LOG2E;
    }
    const int skv = tid >> 3, sc = tid & 7;
    const size_t rowb = (size_t)b * SEQ;
    const bf16_t* kg = K + (rowb + skv) * AW + h * HD + sc * 8;
    const bf16_t* vg = V + (rowb + skv) * AW + h * HD + sc * 8;
    const int kst = skv * 128 + ((sc ^ ((skv >> 1) & 7)) * 16);
    const int vst = (sc >> 2) * 4096 + (skv >> 3) * 512 + (skv & 7) * 64 + (sc & 3) * 16;
    u32x4 kreg = *(const u32x4*)(kg + (size_t)(NT - 1) * 64 * AW), vreg = *(const u32x4*)(vg + (size_t)(NT - 1) * 64 * AW);
    const int q = qb * 256 + wave * 32 + r32;
    bf16x8 qr[4];
#pragma unroll
    for (int d0 = 0; d0 < 4; ++d0) qr[d0] = *(const bf16x8*)(Q + (rowb + q) * AW + h * HD + d0 * 16 + hi * 8);
    *(LAS u32x4*)(lds + AL_K + kst) = kreg; *(LAS u32x4*)(lds + AL_V + vst) = vreg;
    __syncthreads();
    float fqm = FS[q];
    float lsum = 0.f; bool first = true;
    f32x16 o0 = {}, o1 = {};
    const int qmax = qb * 256 + wave * 32 + 31;
    int koff[4];
#pragma unroll
    for (int d0 = 0; d0 < 4; ++d0) koff[d0] = r32 * 128 + (((2 * d0 + hi) ^ ((r32 >> 1) & 7)) * 16);
    const int voff = ((lane >> 4) & 1) * 32 + (lane & 3) * 8 + (4 * hi + ((lane & 15) >> 2)) * 64;
    for (int it = 0; it < NT; ++it) {
        const int t = NT - 1 - it;
        const int cur = (it & 1) * 8192;
        if (t > 0) { kreg = *(const u32x4*)(kg + (size_t)(t - 1) * 64 * AW); vreg = *(const u32x4*)(vg + (size_t)(t - 1) * 64 * AW); }
        if (64 * t <= qmax) {
            const LAS unsigned char* Kb = lds + AL_K + cur; const LAS unsigned char* Vb = lds + AL_V + cur;
            const int kv0 = 64 * t;
            f32x16 p0, p1;
#pragma unroll
            for (int j = 0; j < 4; ++j) {
                const f32x4 f0 = *(const LAS f32x4*)(FS + kv0 + 4 * hi + 8 * j), f1 = *(const LAS f32x4*)(FS + kv0 + 32 + 4 * hi + 8 * j);
#pragma unroll
                for (int e = 0; e < 4; ++e) { p0[4 * j + e] = fqm - f0[e]; p1[4 * j + e] = fqm - f1[e]; }
            }
#pragma unroll
            for (int d0 = 0; d0 < 4; ++d0) {
                const bf16x8 k0 = *(const LAS bf16x8*)(Kb + koff[d0]); const bf16x8 k1 = *(const LAS bf16x8*)(Kb + koff[d0] + 32 * 128);
                p0 = __builtin_amdgcn_mfma_f32_32x32x16_bf16(k0, qr[d0], p0, 0, 0, 0);
                p1 = __builtin_amdgcn_mfma_f32_32x32x16_bf16(k1, qr[d0], p1, 0, 0, 0);
            }
            if (kv0 + 63 > q - r32) {
#pragma unroll
                for (int r = 0; r < 16; ++r) { const int kv = kv0 + crow(r, hi); if (kv > q) p0[r] = -INFINITY; if (kv + 32 > q) p1[r] = -INFINITY; }
            }
            float rm = fmaxf(p0[0], p1[0]);
#pragma unroll
            for (int r = 1; r < 16; ++r) rm = fmaxf(rm, fmaxf(p0[r], p1[r]));
            rm = fmaxf(rm, __shfl_xor(rm, 32));
            if (first || __any(rm > 0.f)) {
                const float dl = first ? rm : fmaxf(rm, 0.f);
                const float alpha = __builtin_amdgcn_exp2f(-dl);
                fqm -= dl; lsum *= alpha;
#pragma unroll
                for (int r = 0; r < 16; ++r) { p0[r] -= dl; p1[r] -= dl; o0[r] *= alpha; o1[r] *= alpha; }
                first = false;
            }
            float ps = 0.f;
#pragma unroll
            for (int r = 0; r < 16; ++r) { p0[r] = __builtin_amdgcn_exp2f(p0[r]); p1[r] = __builtin_amdgcn_exp2f(p1[r]); ps += p0[r] + p1[r]; }
            lsum += ps;
            u32x4 pw[4];
#pragma unroll
            for (int e = 0; e < 4; ++e) { pw[0][e] = pk_bf16(p0[2 * e], p0[2 * e + 1]); pw[1][e] = pk_bf16(p0[8 + 2 * e], p0[9 + 2 * e]);
                                          pw[2][e] = pk_bf16(p1[2 * e], p1[2 * e + 1]); pw[3][e] = pk_bf16(p1[8 + 2 * e], p1[9 + 2 * e]); }
#pragma unroll
            for (int ks = 0; ks < 4; ++ks) {
                const bf16x8 pf = __builtin_bit_cast(bf16x8, pw[ks]);
                typedef short v4i16_t __attribute__((ext_vector_type(4)));
                const s16x4 a0 = __builtin_bit_cast(s16x4, __builtin_amdgcn_ds_read_tr16_b64_v4i16((LAS v4i16_t*)(Vb + voff + ks * 1024)));
                const s16x4 a1 = __builtin_bit_cast(s16x4, __builtin_amdgcn_ds_read_tr16_b64_v4i16((LAS v4i16_t*)(Vb + voff + ks * 1024 + 512)));
                const s16x4 c0 = __builtin_bit_cast(s16x4, __builtin_amdgcn_ds_read_tr16_b64_v4i16((LAS v4i16_t*)(Vb + voff + 4096 + ks * 1024)));
                const s16x4 c1 = __builtin_bit_cast(s16x4, __builtin_amdgcn_ds_read_tr16_b64_v4i16((LAS v4i16_t*)(Vb + voff + 4096 + ks * 1024 + 512)));
                const bf16x8 v0 = (bf16x8){a0[0], a0[1], a0[2], a0[3], a1[0], a1[1], a1[2], a1[3]};
                const bf16x8 v1 = (bf16x8){c0[0], c0[1], c0[2], c0[3], c1[0], c1[1], c1[2], c1[3]};
                o0 = __builtin_amdgcn_mfma_f32_32x32x16_bf16(v0, pf, o0, 0, 0, 0);
                o1 = __builtin_amdgcn_mfma_f32_32x32x16_bf16(v1, pf, o1, 0, 0, 0);
            }
        }
        if (t > 0) { const int nxt = ((it + 1) & 1) * 8192; *(LAS u32x4*)(lds + AL_K + nxt + kst) = kreg; *(LAS u32x4*)(lds + AL_V + nxt + vst) = vreg; }
        __syncthreads();
    }
    lsum += __shfl_xor(lsum, 32);
    const float inv = 1.f / lsum;
    bf16_t* orow = MIX + (rowb + q) * DM + h * HD + 4 * hi;
#pragma unroll
    for (int j = 0; j < 4; ++j) {
        u32x2 w0, w1;
        w0.x = pk_bf16(o0[4 * j] * inv, o0[4 * j + 1] * inv); w0.y = pk_bf16(o0[4 * j + 2] * inv, o0[4 * j + 3] * inv);
        w1.x = pk_bf16(o1[4 * j] * inv, o1[4 * j + 1] * inv); w1.y = pk_bf16(o1[4 * j + 2] * inv, o1[4 * j + 3] * inv);
        *(u32x2*)(orow + 8 * j) = w0; *(u32x2*)(orow + 32 + 8 * j) = w1;
    }
}

template <int GI>
__device__ __forceinline__ void pool_item(const Args& a, int l, int rg16, int lane) {
    constexpr int W = 2 << GI;
    const bf16_t* U = (const bf16_t*)(a.ws + WS_U); bf16_t* MIX = (bf16_t*)(a.ws + WS_MIX);
    const bf16_t* PW = (const bf16_t*)(a.ws + WS_W0 + (size_t)l * WS_WL + WO_PW) + (size_t)GI * 128 * 128;
    const int fr = lane & 15, fq = lane >> 4;
    const bf16_t* PWl = PW + (size_t)fr * 128 + 8 * fq; asm volatile("" : "+v"(PWl));
    const int row = rg16 * 16 + fr, t = row & (SEQ - 1);
    const int cnt = (t + 1) < W ? (t + 1) : W; const float rc = 1.f / (float)cnt;
    bf16x8 af[4];
#pragma unroll
    for (int ks = 0; ks < 4; ++ks) {
        const bf16_t* up = U + (size_t)row * AW + 128 * GI + 32 * ks + 8 * fq;
        const u32x4 self = *(const u32x4*)up;
        float sm[8];
#pragma unroll
        for (int e = 0; e < 4; ++e) { sm[2 * e] = bf_lo(self[e]); sm[2 * e + 1] = bf_hi(self[e]); }
#pragma unroll
        for (int j = 1; j < W; ++j) { const u32x4 v = *(const u32x4*)(up - (size_t)(j < cnt ? j : 0) * AW); const float m = j < cnt ? 1.f : 0.f;
#pragma unroll
            for (int e = 0; e < 4; ++e) { sm[2 * e] += m * bf_lo(v[e]); sm[2 * e + 1] += m * bf_hi(v[e]); } }
        u32x4 pk;
#pragma unroll
        for (int e = 0; e < 4; ++e) pk[e] = pk_bf16(sm[2 * e] * rc - bf_lo(self[e]), sm[2 * e + 1] * rc - bf_hi(self[e]));
        af[ks] = __builtin_bit_cast(bf16x8, pk);
        asm volatile("" : "+v"(af[ks]) :: "memory");
    }
#pragma unroll
    for (int nt = 0; nt < 8; ++nt) {
        f32x4 acc = (f32x4){0.f, 0.f, 0.f, 0.f};
#pragma unroll
        for (int ks = 0; ks < 4; ++ks) { const bf16x8 bfr = *(const bf16x8*)(PWl + (size_t)(16 * nt) * 128 + 32 * ks);
            acc = __builtin_amdgcn_mfma_f32_16x16x32_bf16(bfr, af[ks], acc, 0, 0, 0); }
        const int n0 = 128 * GI + 16 * nt + 4 * fq;
        const f32x4 ps = *(const f32x4*)(a.pool_scale + l * 512 + n0);
        u32x2 o; o.x = pk_bf16(acc[0] * ps[0], acc[1] * ps[1]); o.y = pk_bf16(acc[2] * ps[2], acc[3] * ps[3]);
        *(u32x2*)(MIX + (size_t)row * DM + 512 + n0) = o;
        if (nt & 1) asm volatile("" ::: "memory");
    }
    asm volatile("" ::: "memory");
}

__device__ __forceinline__ void conv_fixup(const Args& a, int l, int pm, int tid) {
    const float* raw = (const float*)(a.ws + WS_RAW); bf16_t* Gb = (bf16_t*)(a.ws + WS_G);
    const float* cw = a.conv_w + (size_t)l * 3 * FF2; const float* cb = a.conv_b + (size_t)l * FF2;
    for (int i = tid; i < 4 * 2 * (FF / 4); i += 512) {
        const int c4 = i % (FF / 4), rr = (i / (FF / 4)) & 1, rg = i / (2 * (FF / 4));
        const int range = pm * 4 + rg, row = range * 64 + rr, ch = 4 * c4;
        const bool first = ((range * 64) & (SEQ - 1)) == 0;
        f32x4 cv[2];
#pragma unroll
        for (int bj = 0; bj < 2; ++bj) {
            const int c = bj * FF + ch;
            const f32x4 cur = *(const f32x4*)(raw + ((size_t)range * 4 + rr) * FF2 + c);
            f32x4 p1, p2; const f32x4 z = (f32x4){0.f, 0.f, 0.f, 0.f};
            if (rr == 0) { p1 = first ? z : *(const f32x4*)(raw + ((size_t)(range - 1) * 4 + 3) * FF2 + c); p2 = first ? z : *(const f32x4*)(raw + ((size_t)(range - 1) * 4 + 2) * FF2 + c); }
            else { p1 = *(const f32x4*)(raw + ((size_t)range * 4 + 0) * FF2 + c); p2 = first ? z : *(const f32x4*)(raw + ((size_t)(range - 1) * 4 + 3) * FF2 + c); }
            cv[bj] = *(const f32x4*)(cb + c) + *(const f32x4*)(cw + c) * p2 + *(const f32x4*)(cw + FF2 + c) * p1 + *(const f32x4*)(cw + 2 * FF2 + c) * cur;
        }
        f32x4 gg;
#pragma unroll
        for (int e = 0; e < 4; ++e) { const float x = cv[0][e]; gg[e] = x * __builtin_amdgcn_rcpf(1.f + __builtin_amdgcn_exp2f(-LOG2E * x)) * cv[1][e]; }
        u32x2 w; w.x = pk_bf16(gg[0], gg[1]); w.y = pk_bf16(gg[2], gg[3]);
        *(u32x2*)(Gb + (size_t)row * FF + ch) = w;
    }
}

#define XB_TMO      128
#define XB_XCNT(j)  (256  + 64 * (j))
#define XB_XSUB(j)  (1280 + 64 * (j))
#define XB_XGEN(j)  (2304 + 64 * (j))
#define XB_TOP      3328
#define XB_TOPGEN   3392
#define XCD_BAR_WORDS 3456
#define XB_SPIN_CAP (1u << 18)

__device__ __forceinline__ unsigned xb_ld(unsigned* p)              { return __hip_atomic_load(p, __ATOMIC_RELAXED, __HIP_MEMORY_SCOPE_AGENT); }
__device__ __forceinline__ unsigned xb_add(unsigned* p, unsigned v) { return __hip_atomic_fetch_add(p, v, __ATOMIC_RELAXED, __HIP_MEMORY_SCOPE_AGENT); }
__device__ __forceinline__ unsigned xb_xcc_id() { return (unsigned)__builtin_amdgcn_s_getreg((3 << 11) | 20) & 0xFu; }
#define XB_SPIN(cond, bar) do { unsigned _sp = 0; while (cond) { __builtin_amdgcn_s_sleep(1); \
    if ((++_sp & 255u) == 0u) { if (xb_ld(&(bar)[XB_TMO])) break; if (_sp > XB_SPIN_CAP) { atomicAdd(&(bar)[XB_TMO], 1u); break; } } } } while (0)

struct XcdBarrier {
    unsigned* bar; unsigned x;
    volatile LAS unsigned* st;
};

__device__ __forceinline__ XcdBarrier xcd_barrier_post(unsigned* bar, volatile LAS unsigned* st) {
    XcdBarrier b; b.bar = bar; b.x = xb_xcc_id(); b.st = st;
    if (threadIdx.x == 0) (void)xb_add(&bar[XB_XCNT(b.x)], 1u);
    return b;
}
__device__ __forceinline__ void xcd_barrier_complete(unsigned* bar, unsigned x, unsigned& nloc, unsigned& nx) {
    const unsigned G = gridDim.x * gridDim.y * gridDim.z;
    unsigned sum, cnt, mine, sp = 0u;
    for (;;) {
        sum = 0u; cnt = 0u; mine = 0u;
#pragma unroll
        for (unsigned j = 0; j < 16; ++j) { const unsigned c = xb_ld(&bar[XB_XCNT(j)]); sum += c; cnt += (c > 0u) ? 1u : 0u; mine = (j == x) ? c : mine; }
        if (sum == G) break;
        __builtin_amdgcn_s_sleep(1);
        if ((++sp & 255u) == 0u) { if (xb_ld(&bar[XB_TMO])) break; if (sp > XB_SPIN_CAP) { atomicAdd(&bar[XB_TMO], 1u); break; } }
    }
    nloc = mine > 0u ? mine : 1u; nx = cnt > 0u ? cnt : 1u;
}

__device__ __forceinline__ void xcd_barrier(const XcdBarrier& b) {
    asm volatile("s_waitcnt vmcnt(0)" ::: "memory");
    __syncthreads();
    if (threadIdx.x == 0) {
        unsigned* bar = b.bar;
        __builtin_amdgcn_s_waitcnt(0);
        unsigned nloc = b.st[0], nx = b.st[1];
        if (nloc == 0u) { xcd_barrier_complete(bar, b.x, nloc, nx); b.st[0] = nloc; b.st[1] = nx; }
        const unsigned old = xb_add(&bar[XB_XSUB(b.x)], 1u);
        const unsigned gen = old / nloc;
        if (old + 1u == (gen + 1u) * nloc) {
            __builtin_amdgcn_fence(__ATOMIC_RELEASE, "agent");
            asm volatile("s_waitcnt vmcnt(0)" ::: "memory");
            const unsigned og = xb_add(&bar[XB_TOP], 1u);
            const unsigned tg = og / nx;
            if (og + 1u == (tg + 1u) * nx) xb_add(&bar[XB_TOPGEN], 1u);
            else XB_SPIN(xb_ld(&bar[XB_TOPGEN]) == tg, bar);
            __builtin_amdgcn_fence(__ATOMIC_ACQUIRE, "agent");
            xb_add(&bar[XB_XGEN(b.x)], 1u);
            asm volatile("s_waitcnt vmcnt(0)" ::: "memory");
        } else {
            XB_SPIN(xb_ld(&bar[XB_XGEN(b.x)]) == gen, bar);
            __builtin_amdgcn_fence(__ATOMIC_ACQUIRE, "agent");
            asm volatile("s_waitcnt vmcnt(0)" ::: "memory");
        }
    }
    __syncthreads();
}

__global__ void __launch_bounds__(512, 2) fwd_kernel(Args a) {
    extern __shared__ __attribute__((aligned(16))) unsigned char lds_raw[];
    LAS unsigned char* lds = (LAS unsigned char*)lds_raw;
    cg::grid_group grid = cg::this_grid();
    { volatile LAS unsigned* st0 = (volatile LAS unsigned*)(lds + LDS_BYTES - 64); if (threadIdx.x < 2) st0[threadIdx.x] = 0u; __syncthreads(); }
    XcdBarrier bar = xcd_barrier_post((unsigned*)a.ws, (volatile LAS unsigned*)(lds + LDS_BYTES - 64));
    const int tid0 = threadIdx.x, G = gridDim.x;
    const int lo = a.ph_lo, hi = a.ph_hi;
    int ph = 0;
#define SEAM() do { if (lo <= ph && ph + 1 < hi) { if (ph == 0) grid.sync(); else xcd_barrier(bar); if ((DUP_MASK >> 10) & 1) xcd_barrier(bar); } ++ph; } while (0)
#define RUN() (lo <= ph && ph < hi)
#ifndef PH_MASK
#define PH_MASK 0x3ff
#endif
#define PHM(k) ((PH_MASK >> (k)) & 1)
#ifndef DUP_MASK
#define DUP_MASK 0
#endif
#define DUP(k) for (int rep_ = 0; rep_ < (((DUP_MASK >> (k)) & 1) ? 2 : 1); ++rep_)
#define FRESH() int tid = tid0, l = l0; asm volatile("" : "+v"(tid), "+s"(l)); const int lane = tid & 63, wave = __builtin_amdgcn_readfirstlane(tid >> 6); (void)lane; (void)wave;
    if (PHM(0) && RUN()) DUP(0) { const int l0 = 0; FRESH(); prologue(a, lds, tid, lane, wave, G); }
    SEAM();
    for (int l0 = 0; l0 < NL; ++l0) {
        if (PHM(1) && RUN()) DUP(1) { FRESH(); const float* xres = (l == 0) ? a.x : a.out; norm_phase<true>(a, xres, l, 0, a.n1g + l * DM, lds, tid, lane, wave, G); }
        SEAM();
        if (PHM(2) && RUN()) DUP(2) { FRESH(); unsigned char* wl = a.ws + WS_W0 + (size_t)l * WS_WL; pg8::Gemm g{(const bf16_t*)(a.ws + WS_XN), (const bf16_t*)(wl + WO_IN), MR, 2048, DM}; pg8::StaticOrder S; S.init(MR, 2048, G, (int)blockIdx.x);
            pg8::EpiBf16 E{(bf16_t*)(a.ws + WS_Q), AW, AW, (size_t)MR * AW, QSCALE};
            pg8::gemm_phase<pg8::EpiBf16, pg8::StaticOrder, true, true>(lds, g, S, E, tid); }
        SEAM();
        if (RUN()) { FRESH();
            if (PHM(3)) DUP(3) for (int p = blockIdx.x; p < NB * NH * 4; p += G) { const int bh = p >> 2, s = p & 3;
                attn_unit(a, bh >> 3, bh & 7, 7 - s, lds, tid, lane, wave);
                attn_unit(a, bh >> 3, bh & 7, s, lds, tid, lane, wave); }
            if (PHM(4)) DUP(4) for (int wi = wave * G + (int)blockIdx.x; wi < (MR / 16) * 2; wi += G * 8) {
                const int rg16 = wi >> 1;
                if (wi & 1) { pool_item<1>(a, l, rg16, lane); pool_item<2>(a, l, rg16, lane); } else { pool_item<0>(a, l, rg16, lane); pool_item<3>(a, l, rg16, lane); } }
        }
        SEAM();
        if (PHM(5) && RUN()) for (int rep_ = 0; rep_ < ((((DUP_MASK >> 5) & 1) && l0 == 0) ? 2 : 1); ++rep_) { FRESH(); unsigned char* wl = a.ws + WS_W0 + (size_t)l * WS_WL; const float* xres = (l == 0) ? a.x : a.out; pg8::Gemm g{(const bf16_t*)(a.ws + WS_MIX), (const bf16_t*)(wl + WO_OUT), MR, DM, DM}; pg8::StaticOrder S; S.init(MR, DM, G, (int)blockIdx.x);
            pg8::EpiRes E{xres, a.out, (const float*)(a.ws + WS_PART), l, 2, 1.f};
            pg8::gemm_phase<pg8::EpiRes, pg8::StaticOrder, true, true>(lds, g, S, E, tid); }
        SEAM();
        if (PHM(6) && RUN()) DUP(6) { FRESH(); norm_phase<false>(a, a.out, l, 3, a.n2g + l * DM, lds, tid, lane, wave, G); }
        SEAM();
        if (PHM(7) && RUN()) DUP(7) { FRESH(); unsigned char* wl = a.ws + WS_W0 + (size_t)l * WS_WL; pg8::Gemm g{(const bf16_t*)(a.ws + WS_XN), (const bf16_t*)(wl + WO_UP), MR, FF2, DM}; pg8::StaticOrder S; S.init(MR, FF2, G, (int)blockIdx.x);
            pg8::EpiConv E{(bf16_t*)(a.ws + WS_G), (float*)(a.ws + WS_RAW), a.conv_w + (size_t)l * 3 * FF2, a.conv_b + (size_t)l * FF2};
            pg8::gemm_phase<pg8::EpiConv, pg8::StaticOrder, true, true>(lds, g, S, E, tid); }
        SEAM();
        if (PHM(8) && RUN()) for (int rep_ = (((DUP_MASK >> 8) & 1) ? 0 : 1); rep_ < 2; ++rep_) { FRESH(); unsigned char* wl = a.ws + WS_W0 + (size_t)l * WS_WL; pg8::Gemm g{(const bf16_t*)(a.ws + WS_G), (const bf16_t*)(wl + WO_DN), MR, DM, FF}; pg8::StaticOrder S; S.init(MR, DM, G, (int)blockIdx.x);
            pg8::Unit u; for (int i = 0; S.next(i, u); ++i) conv_fixup(a, l, u.pm, tid);
            asm volatile("s_waitcnt vmcnt(0)" ::: "memory"); __builtin_amdgcn_fence(__ATOMIC_ACQUIRE, "agent"); asm volatile("s_waitcnt vmcnt(0)" ::: "memory"); __syncthreads();
            pg8::EpiRes E{a.out, a.out, (const float*)(a.ws + WS_PART), l, 5, rep_ == 0 ? 0.f : 1.f};
            pg8::gemm_phase<pg8::EpiRes, pg8::StaticOrder, true, true>(lds, g, S, E, tid); }
        SEAM();
    }
    if (PHM(9) && RUN()) { const int l0 = 0; FRESH(); final_norm(a, lane, wave, G); }
#undef SEAM
#undef RUN
}

#ifndef N_LAUNCH_MODE
#define N_LAUNCH_MODE 1
#endif
extern "C" void kernel_launch(void* const* d_in, const int* in_sizes, int n_in, void* d_out, int out_size, void* d_ws, size_t ws_size, hipStream_t stream) {
    static int grid = 0;
    if (grid == 0) {
        if (n_in != 16 || out_size != MR * DM || ws_size < WS_END) { fprintf(stderr, "kernel_launch: unexpected shapes (n_in %d out %d ws %zu)\n", n_in, out_size, ws_size); grid = -1; return; }
        int dev = 0, cus = 0, per_cu = 0;
        hipGetDevice(&dev); hipDeviceGetAttribute(&cus, hipDeviceAttributeMultiprocessorCount, dev);
        if (hipFuncSetAttribute((const void*)fwd_kernel, hipFuncAttributeMaxDynamicSharedMemorySize, LDS_BYTES) != hipSuccess) { fprintf(stderr, "kernel_launch: hipFuncSetAttribute failed\n"); grid = -1; return; }
        if (hipOccupancyMaxActiveBlocksPerMultiprocessor(&per_cu, (const void*)fwd_kernel, 512, LDS_BYTES) != hipSuccess || per_cu < 1) { fprintf(stderr, "kernel_launch: occupancy query says %d\n", per_cu); (void)hipGetLastError(); per_cu = 1; }
        grid = cus * 1;
        if (grid > cus * per_cu) grid = cus * per_cu;
    }
    if (grid < 0) return;
    if (hipMemsetAsync(d_ws, 0, 16384, stream) != hipSuccess) { fprintf(stderr, "kernel_launch: memset failed\n"); return; }
    Args a{};
    a.x = (const float*)d_in[0]; a.c = (const float*)d_in[1]; a.mod_w = (const float*)d_in[2]; a.mod_b = (const float*)d_in[3]; a.n1g = (const float*)d_in[4]; a.n2g = (const float*)d_in[5];
    a.w_in = (const float*)d_in[6]; a.b_f = (const float*)d_in[7]; a.pool_w = (const float*)d_in[8]; a.pool_scale = (const float*)d_in[9]; a.w_out = (const float*)d_in[10];
    a.ffn_up = (const float*)d_in[11]; a.conv_w = (const float*)d_in[12]; a.conv_b = (const float*)d_in[13]; a.ffn_down = (const float*)d_in[14]; a.final_g = (const float*)d_in[15];
    a.out = (float*)d_out; a.ws = (unsigned char*)d_ws;
    constexpr int NPH = 1 + 7 * NL + 1;
#if N_LAUNCH_MODE == 1
    a.ph_lo = 0; a.ph_hi = NPH;
    void* args[] = {&a};
    hipError_t e = hipLaunchCooperativeKernel((const void*)fwd_kernel, dim3(grid), dim3(512), args, LDS_BYTES, stream);
    if (e != hipSuccess) fprintf(stderr, "cooperative launch failed: %s (grid %d)\n", hipGetErrorString(e), grid);
#else
    for (int p = 0; p < NPH; ++p) { a.ph_lo = p; a.ph_hi = p + 1; hipLaunchKernelGGL(fwd_kernel, dim3(grid), dim3(512), LDS_BYTES, stream, a); }
#endif
}
```

```cpp
#include <hip/hip_runtime.h>
#include <hip/hip_cooperative_groups.h>
#include <cstdio>
#include <cstdint>
namespace cg = cooperative_groups;
namespace pg8 {
#define PG8_LAS __attribute__((address_space(3)))
typedef unsigned short bf16_t;
typedef short bf16x8 __attribute__((ext_vector_type(8)));
typedef float f32x4 __attribute__((ext_vector_type(4)));
typedef unsigned u32x4 __attribute__((ext_vector_type(4)));
constexpr int BM = 256, BK = 64, HALF = 128, HTB = HALF * BK * 2  , STAGE_BYTES = 8 * HTB, NXCD = 8, WGM = 8;

__host__ __device__ __forceinline__ int lds_byte(int r, int c) { const int st = (r >> 4) * 2 + (c >> 5), rr = r & 15, cc = c & 31, ob = rr * 64 + cc * 2; return st * 1024 + (ob ^ (((ob >> 9) & 1) << 5)); }
__host__ __device__ __forceinline__ void stage_rc(int b, int& R, int& C) { const int st = b / 1024, sb = b % 1024, swz = sb ^ (((sb >> 9) & 1) << 5); R = (st >> 1) * 16 + swz / 64; C = (st & 1) * 32 + (swz % 64) / 2; }
__host__ __device__ __forceinline__ int perm32(int rho) { const int n = rho >> 4, i = rho & 15; return 8 * (i >> 2) + 4 * n + (i & 3); }

struct Unit { int pm, pn; };
struct Gemm { const bf16_t* A; const bf16_t* Bt; int M, N, K; };

struct StaticOrder {
    int nM, nN, nwg, G, c;
    __host__ __device__ void init(int M, int N, int G_, int c_) { nM = M / BM; nN = N / BM; nwg = nM * nN; G = G_; c = c_; }
    __host__ __device__ bool next(int i, Unit& u) const {
        const long L = (long)i * G + c; if (L >= nwg) return false;
        int wgid = (int)L; { const int q = nwg / NXCD, r = nwg % NXCD, xcd = wgid % NXCD, off = wgid / NXCD; wgid = (xcd < r ? xcd * (q + 1) : r * (q + 1) + (xcd - r) * q) + off; }
        const int nig = WGM * nN, gid = wgid / nig, fm = gid * WGM, gsz = (nM - fm) < WGM ? (nM - fm) : WGM;
        u.pm = fm + ((wgid % nig) % gsz); u.pn = (wgid % nig) / gsz; return true;
    }
    __device__ __forceinline__ void a_ready(const Unit&) const {}
    __device__ __forceinline__ void done(const Unit&) const {}
};

__device__ __forceinline__ unsigned cvt_pk_bf16(float lo, float hi) { unsigned r; asm volatile("v_cvt_pk_bf16_f32 %0, %1, %2" : "=v"(r) : "v"(lo), "v"(hi)); return r; }
typedef unsigned u32x2 __attribute__((ext_vector_type(2)));
struct EpiBf16 {
    static constexpr bool PERM = true, AFTER_DRAIN = false;
    bf16_t* O; int ldc; int split_cols; size_t split_stride; float scale0;
    __device__ __forceinline__ void operator()(const f32x4 (&acc)[2][2][4][2], const Unit& u, int wr, int wc, int fr, int fq) const {
        const int row0 = u.pm * BM + wr * 64 + fr; int colt = u.pn * BM; bf16_t* base = O;
        float sc = 1.f; { const int t = colt / split_cols; base += (size_t)t * split_stride; colt -= t * split_cols; if (t == 0) sc = scale0; }
        const int col0 = colt + wc * 32 + 8 * fq;
#pragma unroll
        for (int ai = 0; ai < 2; ++ai)
#pragma unroll
            for (int m = 0; m < 4; ++m) { bf16_t* rowp = base + (size_t)(row0 + ai * HALF + m * 16) * ldc + col0;
#pragma unroll
                for (int bj = 0; bj < 2; ++bj) { f32x4 v0 = acc[ai][bj][m][0] * sc, v1 = acc[ai][bj][m][1] * sc;
                    u32x4 w; w.x = cvt_pk_bf16(v0[0], v0[1]); w.y = cvt_pk_bf16(v0[2], v0[3]); w.z = cvt_pk_bf16(v1[0], v1[1]); w.w = cvt_pk_bf16(v1[2], v1[3]);
                    *(u32x4*)(rowp + bj * HALF) = w; } }
    }
};
struct EpiRes {
    static constexpr bool PERM = false, AFTER_DRAIN = false;
    const float* base; float* out; const float* part; int l, which; float gscale;
    __device__ __forceinline__ void operator()(const f32x4 (&acc)[2][2][4][2], const Unit& u, int wr, int wc, int fr, int fq) const {
        const int b = u.pm >> 3; const int col0 = u.pn * BM + wc * 32 + 4 * fq;
        f32x4 gv[2][2];
#pragma unroll
        for (int bj = 0; bj < 2; ++bj)
#pragma unroll
            for (int n = 0; n < 2; ++n) { f32x4 s = (f32x4){0.f, 0.f, 0.f, 0.f};
#pragma unroll
                for (int kc = 0; kc < 8; ++kc) s += *(const f32x4*)(part + ((size_t)((kc * 2 + l) * 8 + b)) * 6144 + which * 1024 + col0 + bj * HALF + n * 16);
                gv[bj][n] = s * gscale; }
#pragma unroll
        for (int ai = 0; ai < 2; ++ai)
#pragma unroll
            for (int m = 0; m < 4; ++m) { const size_t off = (size_t)(u.pm * BM + ai * HALF + wr * 64 + m * 16 + fr) * 1024 + col0;
#pragma unroll
                for (int bj = 0; bj < 2; ++bj)
#pragma unroll
                    for (int n = 0; n < 2; ++n) { const f32x4 bs = *(const f32x4*)(base + off + bj * HALF + n * 16);
                        *(f32x4*)(out + off + bj * HALF + n * 16) = bs + gv[bj][n] * acc[ai][bj][m][n]; }
                if (m & 1) asm volatile("" ::: "memory"); }
    }
};
__device__ __forceinline__ float dpp_ror1(float v) { return __builtin_bit_cast(float, __builtin_amdgcn_mov_dpp(__builtin_bit_cast(int, v), 0x121, 0xf, 0xf, true)); }
__device__ __forceinline__ float dpp_ror2(float v) { return __builtin_bit_cast(float, __builtin_amdgcn_mov_dpp(__builtin_bit_cast(int, v), 0x122, 0xf, 0xf, true)); }
struct EpiConv {
    static constexpr bool PERM = true, AFTER_DRAIN = false;
    bf16_t* Gout; float* raw; const float* cw; const float* cb;
    __device__ __forceinline__ void operator()(const f32x4 (&acc)[2][2][4][2], const Unit& u, int wr, int wc, int fr, int fq) const {
        const int ch0 = u.pn * 128 + wc * 32 + 8 * fq;
#pragma unroll
        for (int n = 0; n < 2; ++n) {
            const int ch = ch0 + 4 * n;
            f32x4 w0[2], w1[2], w2[2], bb[2];
#pragma unroll
            for (int bj = 0; bj < 2; ++bj) { const int c = bj * 2816 + ch;
                w0[bj] = *(const f32x4*)(cw + c); w1[bj] = *(const f32x4*)(cw + 5632 + c); w2[bj] = *(const f32x4*)(cw + 2 * 5632 + c); bb[bj] = *(const f32x4*)(cb + c); }
#pragma unroll
            for (int ai = 0; ai < 2; ++ai)
#pragma unroll
                for (int m = 0; m < 4; ++m) {
                    const int row = u.pm * BM + ai * HALF + wr * 64 + m * 16 + fr;
                    f32x4 cv[2];
#pragma unroll
                    for (int bj = 0; bj < 2; ++bj) {
                        const f32x4 cur = acc[ai][bj][m][n]; const f32x4 prv = acc[ai][bj][m > 0 ? m - 1 : 0][n];
                        f32x4 p1, p2;
#pragma unroll
                        for (int e = 0; e < 4; ++e) { const float c1 = dpp_ror1(cur[e]), c2 = dpp_ror2(cur[e]), q1 = dpp_ror1(prv[e]), q2 = dpp_ror2(prv[e]);
                            p1[e] = fr >= 1 ? c1 : q1; p2[e] = fr >= 2 ? c2 : q2; }
                        cv[bj] = bb[bj] + w0[bj] * p2 + w1[bj] * p1 + w2[bj] * cur;
                        if (m == 0 && fr < 2) *(f32x4*)(raw + ((size_t)(row >> 6) * 4 + fr) * 5632 + bj * 2816 + ch) = cur;
                        if (m == 3 && fr >= 14) *(f32x4*)(raw + ((size_t)(row >> 6) * 4 + (fr - 12)) * 5632 + bj * 2816 + ch) = cur;
                    }
                    if (!(m == 0 && fr < 2)) {
                        f32x4 g;
#pragma unroll
                        for (int e = 0; e < 4; ++e) { const float x = cv[0][e]; g[e] = x * __builtin_amdgcn_rcpf(1.f + __builtin_amdgcn_exp2f(-1.4426950408889634f * x)) * cv[1][e]; }
                        u32x2 w; w.x = cvt_pk_bf16(g[0], g[1]); w.y = cvt_pk_bf16(g[2], g[3]);
                        *(u32x2*)(Gout + (size_t)row * 2816 + ch) = w;
                    }
                }
        }
    }
};
template <class Epi, class Sched, bool ALIGN_EPI = false, bool SP2 = false>
__device__ __forceinline__ void gemm_phase(PG8_LAS unsigned char* lds, const Gemm g, const Sched& S, const Epi& E, const int tid) {
    const int wid = __builtin_amdgcn_readfirstlane(tid >> 6), lane = tid & 63, wr = wid >> 2, wc = wid & 3, fr = lane & 15, fq = lane >> 4;
    const int K = g.K, nt = K / BK;
    unsigned voffA[2], voffB[2];
#pragma unroll
    for (int i = 0; i < 2; ++i) { int R, C; stage_rc(tid * 16 + i * 8192, R, C); const int Rb = Epi::PERM ? ((R & ~31) + perm32(R & 31)) : R;
        voffA[i] = (unsigned)(R * K + C) * 2u; voffB[i] = (unsigned)(Rb * K + C) * 2u; }
    const size_t kstep = (size_t)(BK * 2);
    const size_t hstep = (size_t)HALF * K * 2;
    const size_t tstep = 2 * hstep;
    const unsigned ldsw = (unsigned)wid * 1024u;
    const int aoff = lds_byte(wr * 64 + fr, fq * 8), boff = lds_byte(wc * 32 + fr, fq * 8);
#define PG8_SA(b, h) (((b) * 2 + (h)) * HTB)
#define PG8_SB(b, h) ((4 + (b) * 2 + (h)) * HTB)
#define PG8_STAGE(bufoff, gbase, voff) do { _Pragma("unroll") for (int _i = 0; _i < 2; ++_i) \
        __builtin_amdgcn_global_load_lds((const unsigned*)((const char*)(gbase) + (voff)[_i]), (PG8_LAS unsigned*)(lds + (bufoff) + ldsw + _i * 8192), 16, 0, 0); } while (0)
#define PG8_LDA(dst, b, h) do { _Pragma("unroll") for (int m = 0; m < 4; ++m) _Pragma("unroll") for (int k = 0; k < 2; ++k) dst[m][k] = *(const PG8_LAS bf16x8*)(lds + PG8_SA(b, h) + aoff + m * 2048 + k * 1024); } while (0)
#define PG8_LDB(dst, b, h) do { _Pragma("unroll") for (int n = 0; n < 2; ++n) _Pragma("unroll") for (int k = 0; k < 2; ++k) dst[n][k] = *(const PG8_LAS bf16x8*)(lds + PG8_SB(b, h) + boff + n * 2048 + k * 1024); } while (0)
#define PG8_MMA(ai, bj, At, Bt) do { __builtin_amdgcn_s_setprio(1); _Pragma("unroll") for (int m = 0; m < 4; ++m) _Pragma("unroll") for (int n = 0; n < 2; ++n) _Pragma("unroll") for (int k = 0; k < 2; ++k) \
        acc[ai][bj][m][n] = __builtin_amdgcn_mfma_f32_16x16x32_bf16(Bt[n][k], At[m][k], acc[ai][bj][m][n], 0, 0, 0); __builtin_amdgcn_s_setprio(0); } while (0)
#define PG8_WAIT_V(n) asm volatile("s_waitcnt vmcnt(" #n ")" ::: "memory")
#define PG8_WAIT_L(n) asm volatile("s_waitcnt lgkmcnt(" #n ")" ::: "memory")
#define PG8_BAR __builtin_amdgcn_s_barrier()
#define PG8_SCHED __builtin_amdgcn_sched_barrier(0)
    Unit cur, nxt; int ui = 0;
    if (!S.next(0, cur)) return;
    f32x4 acc[2][2][4][2];
#pragma unroll
    for (int a = 0; a < 2; ++a)
#pragma unroll
        for (int b = 0; b < 2; ++b)
#pragma unroll
            for (int m = 0; m < 4; ++m)
#pragma unroll
                for (int n = 0; n < 2; ++n) acc[a][b][m][n] = (f32x4){0.f, 0.f, 0.f, 0.f};
    bf16x8 At[4][2], B0[2][2], B1[2][2];
    const char* cA = (const char*)g.A + (size_t)cur.pm * tstep; const char* cB = (const char*)g.Bt + (size_t)cur.pn * tstep;
    S.a_ready(cur);
    if constexpr (SP2) {
        PG8_STAGE(PG8_SB(0, 0), cB, voffB); PG8_STAGE(PG8_SB(0, 1), cB + hstep, voffB); PG8_STAGE(PG8_SA(0, 0), cA, voffA); PG8_STAGE(PG8_SA(0, 1), cA + hstep, voffA);
        if (wr == 1) PG8_BAR;
        PG8_WAIT_V(2); PG8_BAR;
        PG8_STAGE(PG8_SB(1, 0), cB + kstep, voffB); PG8_STAGE(PG8_SA(1, 0), cA + kstep, voffA); PG8_STAGE(PG8_SB(1, 1), cB + hstep + kstep, voffB);
        PG8_WAIT_V(6); PG8_BAR;
    } else {
        PG8_STAGE(PG8_SB(0, 0), cB, voffB); PG8_STAGE(PG8_SA(0, 0), cA, voffA); PG8_STAGE(PG8_SB(0, 1), cB + hstep, voffB); PG8_STAGE(PG8_SA(0, 1), cA + hstep, voffA);
        if (wr == 1) PG8_BAR;
        PG8_WAIT_V(4); PG8_BAR;
        PG8_STAGE(PG8_SB(1, 0), cB + kstep, voffB); PG8_STAGE(PG8_SA(1, 0), cA + kstep, voffA); PG8_STAGE(PG8_SB(1, 1), cB + hstep + kstep, voffB);
        PG8_WAIT_V(6); PG8_BAR;
    }
    for (;;) {
        const bool has_next = S.next(ui + 1, nxt);
        const char* nA = has_next ? (const char*)g.A + (size_t)nxt.pm * tstep : cA; const char* nB = has_next ? (const char*)g.Bt + (size_t)nxt.pn * tstep : cB;
        for (int t = 0; t < nt; t += 2) {
            const bool last = (t == nt - 2);
            const char* a1 = cA + (size_t)(t + 1) * kstep;
            const char* a2 = last ? nA : cA + (size_t)(t + 2) * kstep; const char* b2 = last ? nB : cB + (size_t)(t + 2) * kstep;
            const char* a3 = a2 + kstep; const char* b3 = b2 + kstep;
            if (last && has_next) S.a_ready(nxt);
            if constexpr (SP2) {
            PG8_LDB(B0, 0, 0); PG8_LDB(B1, 0, 1); PG8_SCHED; PG8_LDA(At, 0, 0); PG8_STAGE(PG8_SA(1, 1), a1 + hstep, voffA);
            PG8_WAIT_V(8); PG8_WAIT_L(0); PG8_BAR; PG8_MMA(0, 0, At, B0); PG8_MMA(0, 1, At, B1); PG8_BAR; PG8_SCHED;
            PG8_LDA(At, 0, 1); PG8_STAGE(PG8_SB(0, 0), b2, voffB); PG8_STAGE(PG8_SB(0, 1), b2 + hstep, voffB); PG8_STAGE(PG8_SA(0, 0), a2, voffA);
            PG8_WAIT_V(8); PG8_WAIT_L(0); PG8_BAR; PG8_MMA(1, 0, At, B0); PG8_MMA(1, 1, At, B1); PG8_BAR; PG8_SCHED;
            PG8_LDB(B0, 1, 0); PG8_LDB(B1, 1, 1); PG8_SCHED; PG8_LDA(At, 1, 0); PG8_STAGE(PG8_SA(0, 1), a2 + hstep, voffA);
            PG8_WAIT_V(8); PG8_WAIT_L(0); PG8_BAR; PG8_MMA(0, 0, At, B0); PG8_MMA(0, 1, At, B1); PG8_BAR; PG8_SCHED;
            PG8_LDA(At, 1, 1); PG8_STAGE(PG8_SB(1, 0), b3, voffB); PG8_STAGE(PG8_SB(1, 1), b3 + hstep, voffB); PG8_STAGE(PG8_SA(1, 0), a3, voffA);
            PG8_WAIT_V(8); PG8_WAIT_L(0); PG8_BAR; PG8_MMA(1, 0, At, B0); PG8_MMA(1, 1, At, B1); PG8_BAR; PG8_SCHED;
            } else {
            PG8_LDB(B0, 0, 0); PG8_SCHED; PG8_LDA(At, 0, 0); PG8_STAGE(PG8_SA(1, 1), a1 + hstep, voffA);
            PG8_WAIT_L(8); PG8_BAR; PG8_WAIT_L(0); PG8_MMA(0, 0, At, B0); PG8_BAR; PG8_SCHED;
            PG8_LDB(B1, 0, 1); PG8_STAGE(PG8_SB(0, 0), b2, voffB);
            PG8_BAR; PG8_WAIT_L(0); PG8_MMA(0, 1, At, B1); PG8_BAR;
            PG8_LDA(At, 0, 1); PG8_STAGE(PG8_SA(0, 0), a2, voffA);
            PG8_BAR; PG8_WAIT_L(0); PG8_MMA(1, 0, At, B0); PG8_BAR; PG8_SCHED;
            PG8_STAGE(PG8_SB(0, 1), b2 + hstep, voffB);
            PG8_WAIT_V(6); PG8_BAR; PG8_MMA(1, 1, At, B1); PG8_BAR;
            PG8_LDB(B0, 1, 0); PG8_SCHED; PG8_LDA(At, 1, 0); PG8_STAGE(PG8_SA(0, 1), a2 + hstep, voffA);
            PG8_WAIT_L(8); PG8_BAR; PG8_WAIT_L(0); PG8_MMA(0, 0, At, B0); PG8_BAR; PG8_SCHED;
            PG8_LDB(B1, 1, 1); PG8_STAGE(PG8_SB(1, 0), b3, voffB);
            PG8_BAR; PG8_WAIT_L(0); PG8_MMA(0, 1, At, B1); PG8_BAR;
            PG8_LDA(At, 1, 1); PG8_STAGE(PG8_SA(1, 0), a3, voffA);
            PG8_BAR; PG8_WAIT_L(0); PG8_MMA(1, 0, At, B0); PG8_BAR; PG8_SCHED;
            PG8_STAGE(PG8_SB(1, 1), b3 + hstep, voffB);
            PG8_WAIT_V(6); PG8_BAR; PG8_MMA(1, 1, At, B1); PG8_BAR;
            }
        }
        if constexpr (ALIGN_EPI) { if (wr == 0) PG8_BAR; }
        if constexpr (!Epi::AFTER_DRAIN) { E(acc, cur, wr, wc, fr, fq); S.done(cur); }
        if (!has_next) break;
#pragma unroll
        for (int a = 0; a < 2; ++a)
#pragma unroll
            for (int b = 0; b < 2; ++b)
#pragma unroll
                for (int m = 0; m < 4; ++m)
#pragma unroll
                    for (int n = 0; n < 2; ++n) acc[a][b][m][n] = (f32x4){0.f, 0.f, 0.f, 0.f};
        cur = nxt; cA = nA; cB = nB; ++ui;
        if constexpr (ALIGN_EPI) { if (wr == 1) PG8_BAR; }
    }
    PG8_WAIT_V(0);
    if constexpr (!ALIGN_EPI) { if (wr == 0) PG8_BAR; }
    PG8_BAR;
    if constexpr (Epi::AFTER_DRAIN) { E.fused(acc, cur, wr, wc, fr, fq, lds, wid, lane); S.done(cur); }
#undef PG8_SA
#undef PG8_SB
#undef PG8_STAGE
#undef PG8_LDA
#undef PG8_LDB
#undef PG8_MMA
#undef PG8_WAIT_V
#undef PG8_WAIT_L
#undef PG8_BAR
#undef PG8_SCHED
}
}
#define LAS __attribute__((address_space(3)))
typedef unsigned short bf16_t;
typedef short bf16x8 __attribute__((ext_vector_type(8)));
typedef short s16x4 __attribute__((ext_vector_type(4)));
typedef float f32x4 __attribute__((ext_vector_type(4)));
typedef float f32x16 __attribute__((ext_vector_type(16)));
typedef unsigned u32x4 __attribute__((ext_vector_type(4)));
typedef unsigned u32x2 __attribute__((ext_vector_type(2)));
constexpr int NB = 8, SEQ = 2048, DM = 1024, MR = NB * SEQ, NH = 8, HD = 64, AW = 512, INC = 2056, FF = 2816, FF2 = 5632, NL = 2;
constexpr float EPS = 1e-6f, LOG2E = 1.4426950408889634f, QSCALE = 0.125f * 1.4426950408889634f;
constexpr size_t MiB = 1u << 20;
constexpr size_t WS_PART = 1 * MiB;
constexpr size_t WS_LF = 4 * MiB;
constexpr size_t WS_W0 = 5 * MiB, WS_WL = 23 * MiB;
constexpr size_t WO_IN = 0, WO_OUT = 4 * MiB, WO_UP = 6 * MiB, WO_DN = 17 * MiB, WO_PW = 22 * MiB + 512 * 1024;
constexpr size_t WS_XN = 52 * MiB;
constexpr size_t WS_Q = 84 * MiB, WS_K = 100 * MiB, WS_V = 116 * MiB, WS_U = 132 * MiB, WS_MIX = 148 * MiB;
constexpr size_t WS_G = 84 * MiB;
constexpr size_t WS_RAW = 180 * MiB;
constexpr size_t WS_END = 202 * MiB;
constexpr int LDS_BYTES = 147456;

__device__ __forceinline__ unsigned pk_bf16(float lo, float hi) { unsigned r; asm volatile("v_cvt_pk_bf16_f32 %0, %1, %2" : "=v"(r) : "v"(lo), "v"(hi)); return r; }
__device__ __forceinline__ float bf_lo(unsigned w) { return __uint_as_float(w << 16); }
__device__ __forceinline__ float bf_hi(unsigned w) { return __uint_as_float(w & 0xffff0000u); }
__device__ __forceinline__ float wave_sum(float v) {
#pragma unroll
    for (int o = 1; o < 64; o <<= 1) v += __shfl_xor(v, o);
    return v;
}

struct Args { const float* x; const float* c; const float* mod_w; const float* mod_b; const float* n1g; const float* n2g; const float* w_in; const float* b_f;
              const float* pool_w; const float* pool_scale; const float* w_out; const float* ffn_up; const float* conv_w; const float* conv_b; const float* ffn_down;
              const float* final_g; float* out; unsigned char* ws; int ph_lo, ph_hi; };

__device__ __forceinline__ void transpose_item(const float* W, int ldn, int k0, int n0src, bf16_t* WT, int K, int dst0, LAS float* scr, int lane) {
#pragma unroll 8
    for (int i = 0; i < 32; ++i) { const int kk = 2 * i + (lane >> 5); scr[kk * 33 + (lane & 31)] = W[(size_t)(k0 + kk) * ldn + n0src + (lane & 31)]; }
    asm volatile("s_waitcnt lgkmcnt(0)" ::: "memory");
    const int c = lane & 7;
#pragma unroll
    for (int j = 0; j < 4; ++j) { const int n = (lane >> 3) + 8 * j; const LAS float* s = scr + (8 * c) * 33 + n;
        u32x4 o; o.x = pk_bf16(s[0 * 33], s[1 * 33]); o.y = pk_bf16(s[2 * 33], s[3 * 33]); o.z = pk_bf16(s[4 * 33], s[5 * 33]); o.w = pk_bf16(s[6 * 33], s[7 * 33]);
        *(u32x4*)(WT + (size_t)(dst0 + n) * K + k0 + 8 * c) = o; }
    asm volatile("s_waitcnt lgkmcnt(0)" ::: "memory");
}
__device__ __forceinline__ void prologue(const Args& a, LAS unsigned char* lds, int tid, int lane, int wave, int G) {
    LAS float* cact = (LAS float*)(lds + 73728);
    for (int i = tid; i < NB * DM; i += 512) { const int b = i >> 10, k = i & 1023; const float v = a.c[i]; cact[k * 8 + b] = v / (1.f + __expf(-v)); }
    __syncthreads();
    LAS float* scr = (LAS float*)(lds + wave * 8704);
    float* part = (float*)(a.ws + WS_PART);
    const int gw = wave * G + (int)blockIdx.x, NGW = G * 8;
    constexpr int I_MOD = NL * 24 * 8, I_IN = 16 * 64, I_OUT = 16 * 32, I_UP = 16 * 176, I_DN = 44 * 32, I_PW = 4 * 2 * 4, I_L = I_IN + I_OUT + I_UP + I_DN + I_PW;
    for (int it = gw; it < I_MOD + NL * I_L; it += NGW) {
        if (it < I_MOD) {
            const int l = it / 192, r = it % 192, cc = r >> 3, kc = r & 7;
            const float* Wm = a.mod_w + (size_t)l * DM * 6144 + (size_t)(kc * 128) * 6144 + cc * 256 + lane * 4;
            f32x4 acc[8];
#pragma unroll
            for (int b = 0; b < 8; ++b) acc[b] = (f32x4){0.f, 0.f, 0.f, 0.f};
#pragma unroll 8
            for (int kk = 0; kk < 128; ++kk) { const f32x4 w = *(const f32x4*)(Wm + (size_t)kk * 6144);
                const f32x4 c0 = *(const LAS f32x4*)(cact + (kc * 128 + kk) * 8), c1 = *(const LAS f32x4*)(cact + (kc * 128 + kk) * 8 + 4);
                acc[0] += w * c0[0]; acc[1] += w * c0[1]; acc[2] += w * c0[2]; acc[3] += w * c0[3]; acc[4] += w * c1[0]; acc[5] += w * c1[1]; acc[6] += w * c1[2]; acc[7] += w * c1[3]; }
            if (kc == 0) { const f32x4 bv = *(const f32x4*)(a.mod_b + l * 6144 + cc * 256 + lane * 4);
#pragma unroll
                for (int b = 0; b < 8; ++b) acc[b] += bv; }
#pragma unroll
            for (int b = 0; b < 8; ++b) *(f32x4*)(part + ((size_t)((kc * 2 + l) * 8 + b)) * 6144 + cc * 256 + lane * 4) = acc[b];
            continue;
        }
        int r = it - I_MOD; const int l = r / I_L; r -= l * I_L;
        unsigned char* wl = a.ws + WS_W0 + (size_t)l * WS_WL;
        if (r < I_IN) { const int kb = r / 64, nb = r % 64; const int src = nb < 48 ? 32 * nb : 1544 + 32 * (nb - 48);
            transpose_item(a.w_in + (size_t)l * DM * INC, INC, 64 * kb, src, (bf16_t*)(wl + WO_IN), DM, 32 * nb, scr, lane); continue; } r -= I_IN;
        if (r < I_OUT) { const int kb = r / 32, nb = r % 32;
            transpose_item(a.w_out + (size_t)l * DM * DM, DM, 64 * kb, 32 * nb, (bf16_t*)(wl + WO_OUT), DM, 32 * nb, scr, lane); continue; } r -= I_OUT;
        if (r < I_UP) { const int kb = r / 176, nb = r % 176, pn = nb >> 3, wi = nb & 7; const int src = wi < 4 ? 128 * pn + 32 * wi : FF + 128 * pn + 32 * (wi - 4);
            transpose_item(a.ffn_up + (size_t)l * DM * FF2, FF2, 64 * kb, src, (bf16_t*)(wl + WO_UP), DM, 32 * nb, scr, lane); continue; } r -= I_UP;
        if (r < I_DN) { const int kb = r / 32, nb = r % 32;
            transpose_item(a.ffn_down + (size_t)l * FF * DM, DM, 64 * kb, 32 * nb, (bf16_t*)(wl + WO_DN), FF, 32 * nb, scr, lane); continue; } r -= I_DN;
        { const int g = r >> 3, kb = (r >> 2) & 1, nb = r & 3;
            transpose_item(a.pool_w + (size_t)(l * 4 + g) * 128 * 128, 128, 64 * kb, 32 * nb, (bf16_t*)(wl + WO_PW) + (size_t)g * 128 * 128, 128, 32 * nb, scr, lane); }
    }
}

template <bool WITH_F>
__device__ __forceinline__ void norm_phase(const Args& a, const float* xin, int l, int whichb, const float* gvec, LAS unsigned char* lds, int tid, int lane, int wave, int G) {
    LAS float* gm_l = (LAS float*)lds; LAS float* sh_l = gm_l + 1024;
    const float* part = (const float*)(a.ws + WS_PART);
    bf16_t* XN = (bf16_t*)(a.ws + WS_XN);
    float* LF = (float*)(a.ws + WS_LF);
    f32x4 wf[WITH_F ? 16 : 1][2];
    if (WITH_F) {
        const float* wi = a.w_in + (size_t)l * DM * INC + 1536;
#pragma unroll
        for (int j = 0; j < 4; ++j)
#pragma unroll
            for (int e = 0; e < 4; ++e) { const int k = 4 * lane + 256 * j + e; wf[j * 4 + e][0] = *(const f32x4*)(wi + (size_t)k * INC); wf[j * 4 + e][1] = *(const f32x4*)(wi + (size_t)k * INC + 4); }
    }
    for (int blk = blockIdx.x; blk < MR / 64; blk += G) {
        const int b = blk >> 5;
        __syncthreads();
        for (int k = tid; k < DM; k += 512) { float sh = 0.f, sc = 0.f;
#pragma unroll
            for (int kc = 0; kc < 8; ++kc) { const float* p = part + ((size_t)((kc * 2 + l) * 8 + b)) * 6144 + k; sh += p[whichb * 1024]; sc += p[(whichb + 1) * 1024]; }
            gm_l[k] = gvec[k] * (1.f + sc); sh_l[k] = sh; }
        __syncthreads();
        f32x4 gm[4], sh[4];
#pragma unroll
        for (int j = 0; j < 4; ++j) { gm[j] = *(const LAS f32x4*)(gm_l + 4 * lane + 256 * j); sh[j] = *(const LAS f32x4*)(sh_l + 4 * lane + 256 * j); }
#pragma unroll 2
        for (int i = 0; i < 8; ++i) {
            const int row = blk * 64 + wave * 8 + i;
            const f32x4* xr = (const f32x4*)(xin + (size_t)row * DM) + lane;
            f32x4 v[4]; float s = 0.f;
#pragma unroll
            for (int j = 0; j < 4; ++j) { v[j] = xr[64 * j]; s += (v[j].x * v[j].x + v[j].y * v[j].y) + (v[j].z * v[j].z + v[j].w * v[j].w); }
            const float rstd = 1.f / sqrtf(wave_sum(s) * (1.f / DM) + EPS);
            unsigned long long* o8 = (unsigned long long*)(XN + (size_t)row * DM) + lane;
#pragma unroll
            for (int j = 0; j < 4; ++j) { v[j] = v[j] * rstd * gm[j] + sh[j];
                o8[64 * j] = (unsigned long long)pk_bf16(v[j].x, v[j].y) | ((unsigned long long)pk_bf16(v[j].z, v[j].w) << 32); }
            if (WITH_F) {
                f32x4 d0 = (f32x4){0.f, 0.f, 0.f, 0.f}, d1 = d0;
#pragma unroll
                for (int j = 0; j < 4; ++j)
#pragma unroll
                    for (int e = 0; e < 4; ++e) { d0 += wf[j * 4 + e][0] * v[j][e]; d1 += wf[j * 4 + e][1] * v[j][e]; }
                float dd[8] = {d0[0], d0[1], d0[2], d0[3], d1[0], d1[1], d1[2], d1[3]};
#pragma unroll
                for (int h = 0; h < 8; ++h) dd[h] = wave_sum(dd[h]);
                float mine = dd[0];
#pragma unroll
                for (int h = 1; h < 8; ++h) mine = (lane == h) ? dd[h] : mine;
                if (lane < 8) { const float z = mine + a.b_f[l * NH + lane]; const float lf = fminf(z, 0.f) - log1pf(__expf(-fabsf(z)));
                    LF[((size_t)(b * NH + lane)) * SEQ + (row & (SEQ - 1))] = lf; }
            }
        }
    }
}

__device__ __forceinline__ void final_norm(const Args& a, int lane, int wave, int G) {
    f32x4 g[4];
#pragma unroll
    for (int j = 0; j < 4; ++j) g[j] = *((const f32x4*)a.final_g + lane + 64 * j);
    for (int row = blockIdx.x * 8 + wave; row < MR; row += G * 8) {
        f32x4* xr = (f32x4*)(a.out + (size_t)row * DM) + lane;
        f32x4 v[4]; float s = 0.f;
#pragma unroll
        for (int j = 0; j < 4; ++j) { v[j] = xr[64 * j]; s += (v[j].x * v[j].x + v[j].y * v[j].y) + (v[j].z * v[j].z + v[j].w * v[j].w); }
        const float rstd = 1.f / sqrtf(wave_sum(s) * (1.f / DM) + EPS);
#pragma unroll
        for (int j = 0; j < 4; ++j) xr[64 * j] = v[j] * rstd * g[j];
    }
}

__device__ __forceinline__ int crow(int r, int hi) { return (r & 3) + 8 * (r >> 2) + 4 * hi; }
constexpr int AL_FS = 0, AL_WT = 8192, AL_K = 16384, AL_V = 32768;
__device__ __forceinline__ void attn_unit(const Args& a, int b, int h, int qb, LAS unsigned char* lds, int tid, int lane, int wave) {
    const bf16_t* Q = (const bf16_t*)(a.ws + WS_Q); const bf16_t* K = (const bf16_t*)(a.ws + WS_K); const bf16_t* V = (const bf16_t*)(a.ws + WS_V);
    bf16_t* MIX = (bf16_t*)(a.ws + WS_MIX);
    const float* LF = (const float*)(a.ws + WS_LF) + (size_t)(b * NH + h) * SEQ;
    LAS float* FS = (LAS float*)(lds + AL_FS); LAS float* WT = (LAS float*)(lds + AL_WT);
    const int r32 = lane & 31, hi = lane >> 5;
    const int NT = 4 * (qb + 1);
    __syncthreads();
    {
        const f32x4 v = *((const f32x4*)LF + tid);
        const float tot = (v.x + v.y) + (v.z + v.w); float inc = tot;
#pragma unroll
        for (int o = 1; o < 64; o <<= 1) { const float t = __shfl_up(inc, o); if (lane >= o) inc += t; }
        if (lane == 63) WT[wave] = inc;
        __syncthreads();
        float woff = 0.f;
        for (int w = 0; w < wave; ++w) woff += WT[w];
        const float ex = woff + inc - tot;
        f32x4 o; o.x = ex + v.x; o.y = o.x + v.y; o.z = o.y + v.z; o.w = o.z + v.w;
        *(LAS f32x4*)(FS + 4 * tid) = o * LOG2E;
    }
    const int skv = tid >> 3, sc = tid & 7;
    const size_t rowb = (size_t)b * SEQ;
    const bf16_t* kg = K + (rowb + skv) * AW + h * HD + sc * 8;
    const bf16_t* vg = V + (rowb + skv) * AW + h * HD + sc * 8;
    const int kst = skv * 128 + ((sc ^ ((skv >> 1) & 7)) * 16);
    const int vst = (sc >> 2) * 4096 + (skv >> 3) * 512 + (skv & 7) * 64 + (sc & 3) * 16;
    u32x4 kreg = *(const u32x4*)(kg + (size_t)(NT - 1) * 64 * AW), vreg = *(const u32x4*)(vg + (size_t)(NT - 1) * 64 * AW);
    const int q = qb * 256 + wave * 32 + r32;
    bf16x8 qr[4];
#pragma unroll
    for (int d0 = 0; d0 < 4; ++d0) qr[d0] = *(const bf16x8*)(Q + (rowb + q) * AW + h * HD + d0 * 16 + hi * 8);
    *(LAS u32x4*)(lds + AL_K + kst) = kreg; *(LAS u32x4*)(lds + AL_V + vst) = vreg;
    __syncthreads();
    float fqm = FS[q];
    float lsum = 0.f; bool first = true;
    f32x16 o0 = {}, o1 = {};
    const int qmax = qb * 256 + wave * 32 + 31;
    int koff[4];
#pragma unroll
    for (int d0 = 0; d0 < 4; ++d0) koff[d0] = r32 * 128 + (((2 * d0 + hi) ^ ((r32 >> 1) & 7)) * 16);
    const int voff = ((lane >> 4) & 1) * 32 + (lane & 3) * 8 + (4 * hi + ((lane & 15) >> 2)) * 64;
    for (int it = 0; it < NT; ++it) {
        const int t = NT - 1 - it;
        const int cur = (it & 1) * 8192;
        if (t > 0) { kreg = *(const u32x4*)(kg + (size_t)(t - 1) * 64 * AW); vreg = *(const u32x4*)(vg + (size_t)(t - 1) * 64 * AW); }
        if (64 * t <= qmax) {
            const LAS unsigned char* Kb = lds + AL_K + cur; const LAS unsigned char* Vb = lds + AL_V + cur;
            const int kv0 = 64 * t;
            f32x16 p0, p1;
#pragma unroll
            for (int j = 0; j < 4; ++j) {
                const f32x4 f0 = *(const LAS f32x4*)(FS + kv0 + 4 * hi + 8 * j), f1 = *(const LAS f32x4*)(FS + kv0 + 32 + 4 * hi + 8 * j);
#pragma unroll
                for (int e = 0; e < 4; ++e) { p0[4 * j + e] = fqm - f0[e]; p1[4 * j + e] = fqm - f1[e]; }
            }
#pragma unroll
            for (int d0 = 0; d0 < 4; ++d0) {
                const bf16x8 k0 = *(const LAS bf16x8*)(Kb + koff[d0]); const bf16x8 k1 = *(const LAS bf16x8*)(Kb + koff[d0] + 32 * 128);
                p0 = __builtin_amdgcn_mfma_f32_32x32x16_bf16(k0, qr[d0], p0, 0, 0, 0);
                p1 = __builtin_amdgcn_mfma_f32_32x32x16_bf16(k1, qr[d0], p1, 0, 0, 0);
            }
            if (kv0 + 63 > q - r32) {
#pragma unroll
                for (int r = 0; r < 16; ++r) { const int kv = kv0 + crow(r, hi); if (kv > q) p0[r] = -INFINITY; if (kv + 32 > q) p1[r] = -INFINITY; }
            }
            float rm = fmaxf(p0[0], p1[0]);
#pragma unroll
            for (int r = 1; r < 16; ++r) rm = fmaxf(rm, fmaxf(p0[r], p1[r]));
            rm = fmaxf(rm, __shfl_xor(rm, 32));
            if (first || __any(rm > 0.f)) {
                const float dl = first ? rm : fmaxf(rm, 0.f);
                const float alpha = __builtin_amdgcn_exp2f(-dl);
                fqm -= dl; lsum *= alpha;
#pragma unroll
                for (int r = 0; r < 16; ++r) { p0[r] -= dl; p1[r] -= dl; o0[r] *= alpha; o1[r] *= alpha; }
                first = false;
            }
            float ps = 0.f;
#pragma unroll
            for (int r = 0; r < 16; ++r) { p0[r] = __builtin_amdgcn_exp2f(p0[r]); p1[r] = __builtin_amdgcn_exp2f(p1[r]); ps += p0[r] + p1[r]; }
            lsum += ps;
            u32x4 pw[4];
#pragma unroll
            for (int e = 0; e < 4; ++e) { pw[0][e] = pk_bf16(p0[2 * e], p0[2 * e + 1]); pw[1][e] = pk_bf16(p0[8 + 2 * e], p0[9 + 2 * e]);
                                          pw[2][e] = pk_bf16(p1[2 * e], p1[2 * e + 1]); pw[3][e] = pk_bf16(p1[8 + 2 * e], p1[9 + 2 * e]); }
#pragma unroll
            for (int ks = 0; ks < 4; ++ks) {
                const bf16x8 pf = __builtin_bit_cast(bf16x8, pw[ks]);
                typedef short v4i16_t __attribute__((ext_vector_type(4)));
                const s16x4 a0 = __builtin_bit_cast(s16x4, __builtin_amdgcn_ds_read_tr16_b64_v4i16((LAS v4i16_t*)(Vb + voff + ks * 1024)));
                const s16x4 a1 = __builtin_bit_cast(s16x4, __builtin_amdgcn_ds_read_tr16_b64_v4i16((LAS v4i16_t*)(Vb + voff + ks * 1024 + 512)));
                const s16x4 c0 = __builtin_bit_cast(s16x4, __builtin_amdgcn_ds_read_tr16_b64_v4i16((LAS v4i16_t*)(Vb + voff + 4096 + ks * 1024)));
                const s16x4 c1 = __builtin_bit_cast(s16x4, __builtin_amdgcn_ds_read_tr16_b64_v4i16((LAS v4i16_t*)(Vb + voff + 4096 + ks * 1024 + 512)));
                const bf16x8 v0 = (bf16x8){a0[0], a0[1], a0[2], a0[3], a1[0], a1[1], a1[2], a1[3]};
                const bf16x8 v1 = (bf16x8){c0[0], c0[1], c0[2], c0[3], c1[0], c1[1], c1[2], c1[3]};
                o0 = __builtin_amdgcn_mfma_f32_32x32x16_bf16(v0, pf, o0, 0, 0, 0);
                o1 = __builtin_amdgcn_mfma_f32_32x32x16_bf16(v1, pf, o1, 0, 0, 0);
            }
        }
        if (t > 0) { const int nxt = ((it + 1) & 1) * 8192; *(LAS u32x4*)(lds + AL_K + nxt + kst) = kreg; *(LAS u32x4*)(lds + AL_V + nxt + vst) = vreg; }
        __syncthreads();
    }
    lsum += __shfl_xor(lsum, 32);
    const float inv = 1.f / lsum;
    bf16_t* orow = MIX + (rowb + q) * DM + h * HD + 4 * hi;
#pragma unroll
    for (int j = 0; j < 4; ++j) {
        u32x2 w0, w1;
        w0.x = pk_bf16(o0[4 * j] * inv, o0[4 * j + 1] * inv); w0.y = pk_bf16(o0[4 * j + 2] * inv, o0[4 * j + 3] * inv);
        w1.x = pk_bf16(o1[4 * j] * inv, o1[4 * j + 1] * inv); w1.y = pk_bf16(o1[4 * j + 2] * inv, o1[4 * j + 3] * inv);
        *(u32x2*)(orow + 8 * j) = w0; *(u32x2*)(orow + 32 + 8 * j) = w1;
    }
}

template <int GI>
__device__ __forceinline__ void pool_item(const Args& a, int l, int rg16, int lane) {
    constexpr int W = 2 << GI;
    const bf16_t* U = (const bf16_t*)(a.ws + WS_U); bf16_t* MIX = (bf16_t*)(a.ws + WS_MIX);
    const bf16_t* PW = (const bf16_t*)(a.ws + WS_W0 + (size_t)l * WS_WL + WO_PW) + (size_t)GI * 128 * 128;
    int ln = lane; asm volatile("" : "+v"(ln));
    const int fr = ln & 15, fq = ln >> 4;
    const bf16_t* PWl = PW + (size_t)fr * 128 + 8 * fq;
    const int row = rg16 * 16 + fr, t = row & (SEQ - 1);
    const int cnt = (t + 1) < W ? (t + 1) : W; const float rc = 1.f / (float)cnt;
    bf16x8 af[4];
#pragma unroll
    for (int ks = 0; ks < 4; ++ks) {
        const bf16_t* up = U + (size_t)row * AW + 128 * GI + 32 * ks + 8 * fq;
        const u32x4 self = *(const u32x4*)up;
        float sm[8];
#pragma unroll
        for (int e = 0; e < 4; ++e) { sm[2 * e] = bf_lo(self[e]); sm[2 * e + 1] = bf_hi(self[e]); }
#pragma unroll
        for (int j = 1; j < W; ++j) { const u32x4 v = *(const u32x4*)(up - (size_t)(j < cnt ? j : 0) * AW); const float m = j < cnt ? 1.f : 0.f;
#pragma unroll
            for (int e = 0; e < 4; ++e) { sm[2 * e] += m * bf_lo(v[e]); sm[2 * e + 1] += m * bf_hi(v[e]); } }
        u32x4 pk;
#pragma unroll
        for (int e = 0; e < 4; ++e) pk[e] = pk_bf16(sm[2 * e] * rc - bf_lo(self[e]), sm[2 * e + 1] * rc - bf_hi(self[e]));
        af[ks] = __builtin_bit_cast(bf16x8, pk);
        if (W >= 8) asm volatile("" : "+v"(af[ks]) :: "memory");
    }
    bf16x8 bw[4][4];
#pragma unroll
    for (int nt = 0; nt < 8; ++nt) {
        if ((nt & 3) == 0) {
            if (nt) asm volatile("" ::: "memory");
#pragma unroll
            for (int n2 = 0; n2 < 4; ++n2)
#pragma unroll
                for (int ks = 0; ks < 4; ++ks) bw[n2][ks] = *(const bf16x8*)(PWl + (size_t)(16 * (nt + n2)) * 128 + 32 * ks);
        }
        f32x4 acc = (f32x4){0.f, 0.f, 0.f, 0.f};
#pragma unroll
        for (int ks = 0; ks < 4; ++ks) acc = __builtin_amdgcn_mfma_f32_16x16x32_bf16(bw[nt & 3][ks], af[ks], acc, 0, 0, 0);
        const int n0 = 128 * GI + 16 * nt + 4 * fq;
        const f32x4 ps = *(const f32x4*)(a.pool_scale + l * 512 + n0);
        u32x2 o; o.x = pk_bf16(acc[0] * ps[0], acc[1] * ps[1]); o.y = pk_bf16(acc[2] * ps[2], acc[3] * ps[3]);
        *(u32x2*)(MIX + (size_t)row * DM + 512 + n0) = o;
    }
    asm volatile("" ::: "memory");
}

__device__ __forceinline__ void conv_fixup(const Args& a, int l, int pm, int tid) {
    const float* raw = (const float*)(a.ws + WS_RAW); bf16_t* Gb = (bf16_t*)(a.ws + WS_G);
    const float* cw = a.conv_w + (size_t)l * 3 * FF2; const float* cb = a.conv_b + (size_t)l * FF2;
    for (int i = tid; i < 4 * 2 * (FF / 4); i += 512) {
        const int c4 = i % (FF / 4), rr = (i / (FF / 4)) & 1, rg = i / (2 * (FF / 4));
        const int range = pm * 4 + rg, row = range * 64 + rr, ch = 4 * c4;
        const bool first = ((range * 64) & (SEQ - 1)) == 0;
        f32x4 cv[2];
#pragma unroll
        for (int bj = 0; bj < 2; ++bj) {
            const int c = bj * FF + ch;
            const f32x4 cur = *(const f32x4*)(raw + ((size_t)range * 4 + rr) * FF2 + c);
            f32x4 p1, p2; const f32x4 z = (f32x4){0.f, 0.f, 0.f, 0.f};
            if (rr == 0) { p1 = first ? z : *(const f32x4*)(raw + ((size_t)(range - 1) * 4 + 3) * FF2 + c); p2 = first ? z : *(const f32x4*)(raw + ((size_t)(range - 1) * 4 + 2) * FF2 + c); }
            else { p1 = *(const f32x4*)(raw + ((size_t)range * 4 + 0) * FF2 + c); p2 = first ? z : *(const f32x4*)(raw + ((size_t)(range - 1) * 4 + 3) * FF2 + c); }
            cv[bj] = *(const f32x4*)(cb + c) + *(const f32x4*)(cw + c) * p2 + *(const f32x4*)(cw + FF2 + c) * p1 + *(const f32x4*)(cw + 2 * FF2 + c) * cur;
        }
        f32x4 gg;
#pragma unroll
        for (int e = 0; e < 4; ++e) { const float x = cv[0][e]; gg[e] = x * __builtin_amdgcn_rcpf(1.f + __builtin_amdgcn_exp2f(-LOG2E * x)) * cv[1][e]; }
        u32x2 w; w.x = pk_bf16(gg[0], gg[1]); w.y = pk_bf16(gg[2], gg[3]);
        *(u32x2*)(Gb + (size_t)row * FF + ch) = w;
    }
}

#define XB_TMO      128
#define XB_XCNT(j)  (256  + 64 * (j))
#define XB_XSUB(j)  (1280 + 64 * (j))
#define XB_XGEN(j)  (2304 + 64 * (j))
#define XB_TOP      3328
#define XB_TOPGEN   3392
#define XCD_BAR_WORDS 3456
#define XB_SPIN_CAP (1u << 18)

__device__ __forceinline__ unsigned xb_ld(unsigned* p)              { return __hip_atomic_load(p, __ATOMIC_RELAXED, __HIP_MEMORY_SCOPE_AGENT); }
__device__ __forceinline__ unsigned xb_add(unsigned* p, unsigned v) { return __hip_atomic_fetch_add(p, v, __ATOMIC_RELAXED, __HIP_MEMORY_SCOPE_AGENT); }
__device__ __forceinline__ unsigned xb_xcc_id() { return (unsigned)__builtin_amdgcn_s_getreg((3 << 11) | 20) & 0xFu; }
#define XB_SPIN(cond, bar) do { unsigned _sp = 0; while (cond) { __builtin_amdgcn_s_sleep(1); \
    if ((++_sp & 255u) == 0u) { if (xb_ld(&(bar)[XB_TMO])) break; if (_sp > XB_SPIN_CAP) { atomicAdd(&(bar)[XB_TMO], 1u); break; } } } } while (0)

struct XcdBarrier {
    unsigned* bar; unsigned x;
    volatile LAS unsigned* st;
};

__device__ __forceinline__ XcdBarrier xcd_barrier_post(unsigned* bar, volatile LAS unsigned* st) {
    XcdBarrier b; b.bar = bar; b.x = xb_xcc_id(); b.st = st;
    if (threadIdx.x == 0) (void)xb_add(&bar[XB_XCNT(b.x)], 1u);
    return b;
}
__device__ __forceinline__ void xcd_barrier_complete(unsigned* bar, unsigned x, unsigned& nloc, unsigned& nx) {
    const unsigned G = gridDim.x * gridDim.y * gridDim.z;
    unsigned sum, cnt, mine, sp = 0u;
    for (;;) {
        sum = 0u; cnt = 0u; mine = 0u;
#pragma unroll
        for (unsigned j = 0; j < 16; ++j) { const unsigned c = xb_ld(&bar[XB_XCNT(j)]); sum += c; cnt += (c > 0u) ? 1u : 0u; mine = (j == x) ? c : mine; }
        if (sum == G) break;
        __builtin_amdgcn_s_sleep(1);
        if ((++sp & 255u) == 0u) { if (xb_ld(&bar[XB_TMO])) break; if (sp > XB_SPIN_CAP) { atomicAdd(&bar[XB_TMO], 1u); break; } }
    }
    nloc = mine > 0u ? mine : 1u; nx = cnt > 0u ? cnt : 1u;
}

__device__ __forceinline__ void xcd_barrier(const XcdBarrier& b) {
    asm volatile("s_waitcnt vmcnt(0)" ::: "memory");
    __syncthreads();
    if (threadIdx.x == 0) {
        unsigned* bar = b.bar;
        __builtin_amdgcn_s_waitcnt(0);
        unsigned nloc = b.st[0], nx = b.st[1];
        if (nloc == 0u) { xcd_barrier_complete(bar, b.x, nloc, nx); b.st[0] = nloc; b.st[1] = nx; }
        const unsigned old = xb_add(&bar[XB_XSUB(b.x)], 1u);
        const unsigned gen = old / nloc;
        if (old + 1u == (gen + 1u) * nloc) {
            __builtin_amdgcn_fence(__ATOMIC_RELEASE, "agent");
            asm volatile("s_waitcnt vmcnt(0)" ::: "memory");
            const unsigned og = xb_add(&bar[XB_TOP], 1u);
            const unsigned tg = og / nx;
            if (og + 1u == (tg + 1u) * nx) xb_add(&bar[XB_TOPGEN], 1u);
            else XB_SPIN(xb_ld(&bar[XB_TOPGEN]) == tg, bar);
            __builtin_amdgcn_fence(__ATOMIC_ACQUIRE, "agent");
            xb_add(&bar[XB_XGEN(b.x)], 1u);
            asm volatile("s_waitcnt vmcnt(0)" ::: "memory");
        } else {
            XB_SPIN(xb_ld(&bar[XB_XGEN(b.x)]) == gen, bar);
            __builtin_amdgcn_fence(__ATOMIC_ACQUIRE, "agent");
            asm volatile("s_waitcnt vmcnt(0)" ::: "memory");
        }
    }
    __syncthreads();
}

__global__ void __launch_bounds__(512, 2) fwd_kernel(Args a) {
    extern __shared__ __attribute__((aligned(16))) unsigned char lds_raw[];
    LAS unsigned char* lds = (LAS unsigned char*)lds_raw;
    cg::grid_group grid = cg::this_grid();
    { volatile LAS unsigned* st0 = (volatile LAS unsigned*)(lds + LDS_BYTES - 64); if (threadIdx.x < 2) st0[threadIdx.x] = 0u; __syncthreads(); }
    XcdBarrier bar = xcd_barrier_post((unsigned*)a.ws, (volatile LAS unsigned*)(lds + LDS_BYTES - 64));
    const int tid0 = threadIdx.x, G = gridDim.x;
    const int lo = a.ph_lo, hi = a.ph_hi;
    if (hi < 0) grid.sync();
    int ph = 0;
#define SEAM() do { if (lo <= ph && ph + 1 < hi) { xcd_barrier(bar); if ((DUP_MASK >> 10) & 1) xcd_barrier(bar); } ++ph; } while (0)
#define RUN() (lo <= ph && ph < hi)
#ifndef PH_MASK
#define PH_MASK 0x3ff
#endif
#define PHM(k) ((PH_MASK >> (k)) & 1)
#ifndef DUP_MASK
#define DUP_MASK 0
#endif
#define DUP(k) for (int rep_ = 0; rep_ < (((DUP_MASK >> (k)) & 1) ? 2 : 1); ++rep_)
#define FRESH() int tid = tid0, l = l0; asm volatile("" : "+v"(tid), "+s"(l)); const int lane = tid & 63, wave = __builtin_amdgcn_readfirstlane(tid >> 6); (void)lane; (void)wave;
    if (PHM(0) && RUN()) DUP(0) { const int l0 = 0; FRESH(); prologue(a, lds, tid, lane, wave, G); }
    SEAM();
    for (int l0 = 0; l0 < NL; ++l0) {
        if (PHM(1) && RUN()) DUP(1) { FRESH(); const float* xres = (l == 0) ? a.x : a.out; norm_phase<true>(a, xres, l, 0, a.n1g + l * DM, lds, tid, lane, wave, G); }
        SEAM();
        if (PHM(2) && RUN()) DUP(2) { FRESH(); unsigned char* wl = a.ws + WS_W0 + (size_t)l * WS_WL; pg8::Gemm g{(const bf16_t*)(a.ws + WS_XN), (const bf16_t*)(wl + WO_IN), MR, 2048, DM}; pg8::StaticOrder S; S.init(MR, 2048, G, (int)blockIdx.x);
            pg8::EpiBf16 E{(bf16_t*)(a.ws + WS_Q), AW, AW, (size_t)MR * AW, QSCALE};
            pg8::gemm_phase<pg8::EpiBf16, pg8::StaticOrder, true, true>(lds, g, S, E, tid); }
        SEAM();
        if (RUN()) { FRESH();
            if (PHM(3)) DUP(3) for (int p = blockIdx.x; p < NB * NH * 4; p += G) { const int bh = p >> 2, s = p & 3;
                attn_unit(a, bh >> 3, bh & 7, 7 - s, lds, tid, lane, wave);
                attn_unit(a, bh >> 3, bh & 7, s, lds, tid, lane, wave); }
            if (PHM(4)) DUP(4) for (int wi = wave * G + (int)blockIdx.x; wi < (MR / 16) * 2; wi += G * 8) {
                const int rg16 = wi >> 1;
                if (wi & 1) { pool_item<1>(a, l, rg16, lane); pool_item<2>(a, l, rg16, lane); } else { pool_item<0>(a, l, rg16, lane); pool_item<3>(a, l, rg16, lane); } }
        }
        SEAM();
        if (PHM(5) && RUN()) for (int rep_ = 0; rep_ < ((((DUP_MASK >> 5) & 1) && l0 == 0) ? 2 : 1); ++rep_) { FRESH(); unsigned char* wl = a.ws + WS_W0 + (size_t)l * WS_WL; const float* xres = (l == 0) ? a.x : a.out; pg8::Gemm g{(const bf16_t*)(a.ws + WS_MIX), (const bf16_t*)(wl + WO_OUT), MR, DM, DM}; pg8::StaticOrder S; S.init(MR, DM, G, (int)blockIdx.x);
            pg8::EpiRes E{xres, a.out, (const float*)(a.ws + WS_PART), l, 2, 1.f};
            pg8::gemm_phase<pg8::EpiRes, pg8::StaticOrder, true, true>(lds, g, S, E, tid); }
        SEAM();
        if (PHM(6) && RUN()) DUP(6) { FRESH(); norm_phase<false>(a, a.out, l, 3, a.n2g + l * DM, lds, tid, lane, wave, G); }
        SEAM();
        if (PHM(7) && RUN()) DUP(7) { FRESH(); unsigned char* wl = a.ws + WS_W0 + (size_t)l * WS_WL; pg8::Gemm g{(const bf16_t*)(a.ws + WS_XN), (const bf16_t*)(wl + WO_UP), MR, FF2, DM}; pg8::StaticOrder S; S.init(MR, FF2, G, (int)blockIdx.x);
            pg8::EpiConv E{(bf16_t*)(a.ws + WS_G), (float*)(a.ws + WS_RAW), a.conv_w + (size_t)l * 3 * FF2, a.conv_b + (size_t)l * FF2};
            pg8::gemm_phase<pg8::EpiConv, pg8::StaticOrder, true, true>(lds, g, S, E, tid); }
        SEAM();
        if (PHM(8) && RUN()) for (int rep_ = (((DUP_MASK >> 8) & 1) ? 0 : 1); rep_ < 2; ++rep_) { FRESH(); unsigned char* wl = a.ws + WS_W0 + (size_t)l * WS_WL; pg8::Gemm g{(const bf16_t*)(a.ws + WS_G), (const bf16_t*)(wl + WO_DN), MR, DM, FF}; pg8::StaticOrder S; S.init(MR, DM, G, (int)blockIdx.x);
            pg8::Unit u; for (int i = 0; S.next(i, u); ++i) conv_fixup(a, l, u.pm, tid);
            asm volatile("s_waitcnt vmcnt(0)" ::: "memory"); __builtin_amdgcn_fence(__ATOMIC_ACQUIRE, "agent"); asm volatile("s_waitcnt vmcnt(0)" ::: "memory"); __syncthreads();
            pg8::EpiRes E{a.out, a.out, (const float*)(a.ws + WS_PART), l, 5, rep_ == 0 ? 0.f : 1.f};
            pg8::gemm_phase<pg8::EpiRes, pg8::StaticOrder, true, true>(lds, g, S, E, tid); }
        SEAM();
    }
    if (PHM(9) && RUN()) { const int l0 = 0; FRESH(); final_norm(a, lane, wave, G); }
#undef SEAM
#undef RUN
}

#ifndef N_LAUNCH_MODE
#define N_LAUNCH_MODE 1
#endif
extern "C" void kernel_launch(void* const* d_in, const int* in_sizes, int n_in, void* d_out, int out_size, void* d_ws, size_t ws_size, hipStream_t stream) {
    static int grid = 0;
    if (grid == 0) {
        if (n_in != 16 || out_size != MR * DM || ws_size < WS_END) { fprintf(stderr, "kernel_launch: unexpected shapes (n_in %d out %d ws %zu)\n", n_in, out_size, ws_size); grid = -1; return; }
        int dev = 0, cus = 0, per_cu = 0;
        hipGetDevice(&dev); hipDeviceGetAttribute(&cus, hipDeviceAttributeMultiprocessorCount, dev);
        if (hipFuncSetAttribute((const void*)fwd_kernel, hipFuncAttributeMaxDynamicSharedMemorySize, LDS_BYTES) != hipSuccess) { fprintf(stderr, "kernel_launch: hipFuncSetAttribute failed\n"); grid = -1; return; }
        if (hipOccupancyMaxActiveBlocksPerMultiprocessor(&per_cu, (const void*)fwd_kernel, 512, LDS_BYTES) != hipSuccess || per_cu < 1) { fprintf(stderr, "kernel_launch: occupancy query says %d\n", per_cu); (void)hipGetLastError(); per_cu = 1; }
        grid = cus * 1;
        if (grid > cus * per_cu) grid = cus * per_cu;
    }
    if (grid < 0) return;
    if (hipMemsetAsync(d_ws, 0, 16384, stream) != hipSuccess) { fprintf(stderr, "kernel_launch: memset failed\n"); return; }
    Args a{};
    a.x = (const float*)d_in[0]; a.c = (const float*)d_in[1]; a.mod_w = (const float*)d_in[2]; a.mod_b = (const float*)d_in[3]; a.n1g = (const float*)d_in[4]; a.n2g = (const float*)d_in[5];
    a.w_in = (const float*)d_in[6]; a.b_f = (const float*)d_in[7]; a.pool_w = (const float*)d_in[8]; a.pool_scale = (const float*)d_in[9]; a.w_out = (const float*)d_in[10];
    a.ffn_up = (const float*)d_in[11]; a.conv_w = (const float*)d_in[12]; a.conv_b = (const float*)d_in[13]; a.ffn_down = (const float*)d_in[14]; a.final_g = (const float*)d_in[15];
    a.out = (float*)d_out; a.ws = (unsigned char*)d_ws;
    constexpr int NPH = 1 + 7 * NL + 1;
#if N_LAUNCH_MODE == 1
    a.ph_lo = 0; a.ph_hi = NPH;
    void* args[] = {&a};
    hipError_t e = hipLaunchCooperativeKernel((const void*)fwd_kernel, dim3(grid), dim3(512), args, LDS_BYTES, stream);
    if (e != hipSuccess) fprintf(stderr, "cooperative launch failed: %s (grid %d)\n", hipGetErrorString(e), grid);
#else
    for (int p = 0; p < NPH; ++p) { a.ph_lo = p; a.ph_hi = p + 1; hipLaunchKernelGGL(fwd_kernel, dim3(grid), dim3(512), LDS_BYTES, stream, a); }
#endif
}
```

```cpp
#include <hip/hip_runtime.h>
#include <hip/hip_cooperative_groups.h>
#include <cstdio>
#include <cstdint>
namespace cg = cooperative_groups;
namespace pg8 {
#define PG8_LAS __attribute__((address_space(3)))
typedef unsigned short bf16_t;
typedef short bf16x8 __attribute__((ext_vector_type(8)));
typedef float f32x4 __attribute__((ext_vector_type(4)));
typedef unsigned u32x4 __attribute__((ext_vector_type(4)));
constexpr int BM = 256, BK = 64, HALF = 128, HTB = HALF * BK * 2  , STAGE_BYTES = 8 * HTB, NXCD = 8, WGM = 8;

__host__ __device__ __forceinline__ int lds_byte(int r, int c) { const int st = (r >> 4) * 2 + (c >> 5), rr = r & 15, cc = c & 31, ob = rr * 64 + cc * 2; return st * 1024 + (ob ^ (((ob >> 9) & 1) << 5)); }
__host__ __device__ __forceinline__ void stage_rc(int b, int& R, int& C) { const int st = b / 1024, sb = b % 1024, swz = sb ^ (((sb >> 9) & 1) << 5); R = (st >> 1) * 16 + swz / 64; C = (st & 1) * 32 + (swz % 64) / 2; }
__host__ __device__ __forceinline__ int perm32(int rho) { const int n = rho >> 4, i = rho & 15; return 8 * (i >> 2) + 4 * n + (i & 3); }

struct Unit { int pm, pn; };
struct Gemm { const bf16_t* A; const bf16_t* Bt; int M, N, K; };

struct StaticOrder {
    int nM, nN, nwg, G, c;
    __host__ __device__ void init(int M, int N, int G_, int c_) { nM = M / BM; nN = N / BM; nwg = nM * nN; G = G_; c = c_; }
    __host__ __device__ bool next(int i, Unit& u) const {
        const long L = (long)i * G + c; if (L >= nwg) return false;
        int wgid = (int)L; { const int q = nwg / NXCD, r = nwg % NXCD, xcd = wgid % NXCD, off = wgid / NXCD; wgid = (xcd < r ? xcd * (q + 1) : r * (q + 1) + (xcd - r) * q) + off; }
        const int nig = WGM * nN, gid = wgid / nig, fm = gid * WGM, gsz = (nM - fm) < WGM ? (nM - fm) : WGM;
        u.pm = fm + ((wgid % nig) % gsz); u.pn = (wgid % nig) / gsz; return true;
    }
    __device__ __forceinline__ void a_ready(const Unit&) const {}
    __device__ __forceinline__ void done(const Unit&) const {}
};

typedef float f32x2c __attribute__((ext_vector_type(2))); typedef __bf16 bf16x2c __attribute__((ext_vector_type(2)));
__device__ __forceinline__ unsigned cvt_pk_bf16(float lo, float hi) { f32x2c v = {lo, hi}; bf16x2c b = __builtin_convertvector(v, bf16x2c); return __builtin_bit_cast(unsigned, b); }
typedef unsigned u32x2 __attribute__((ext_vector_type(2)));
struct EpiBf16 {
    static constexpr bool PERM = true, AFTER_DRAIN = false;
    bf16_t* O; int ldc; int split_cols; size_t split_stride; float scale0;
    __device__ __forceinline__ void operator()(const f32x4 (&acc)[2][2][4][2], const Unit& u, int wr, int wc, int fr, int fq) const {
        const int row0 = u.pm * BM + wr * 64 + fr; int colt = u.pn * BM; bf16_t* base = O;
        float sc = 1.f; { const int t = colt / split_cols; base += (size_t)t * split_stride; colt -= t * split_cols; if (t == 0) sc = scale0; }
        const int col0 = colt + wc * 32 + 8 * fq;
#pragma unroll
        for (int ai = 0; ai < 2; ++ai)
#pragma unroll
            for (int m = 0; m < 4; ++m) { bf16_t* rowp = base + (size_t)(row0 + ai * HALF + m * 16) * ldc + col0;
#pragma unroll
                for (int bj = 0; bj < 2; ++bj) { f32x4 v0 = acc[ai][bj][m][0] * sc, v1 = acc[ai][bj][m][1] * sc;
                    u32x4 w; w.x = cvt_pk_bf16(v0[0], v0[1]); w.y = cvt_pk_bf16(v0[2], v0[3]); w.z = cvt_pk_bf16(v1[0], v1[1]); w.w = cvt_pk_bf16(v1[2], v1[3]);
                    *(u32x4*)(rowp + bj * HALF) = w; } }
    }
};
struct EpiRes {
    static constexpr bool PERM = false, AFTER_DRAIN = false;
    const float* base; float* out; const float* part; int l, which; float gscale;
    __device__ __forceinline__ void operator()(const f32x4 (&acc)[2][2][4][2], const Unit& u, int wr, int wc, int fr, int fq) const {
        const int b = u.pm >> 3; const int col0 = u.pn * BM + wc * 32 + 4 * fq;
        f32x4 gv[2][2];
#pragma unroll
        for (int bj = 0; bj < 2; ++bj)
#pragma unroll
            for (int n = 0; n < 2; ++n) { f32x4 s = (f32x4){0.f, 0.f, 0.f, 0.f};
#pragma unroll
                for (int kc = 0; kc < 8; ++kc) s += *(const f32x4*)(part + ((size_t)((kc * 2 + l) * 8 + b)) * 6144 + which * 1024 + col0 + bj * HALF + n * 16);
                gv[bj][n] = s * gscale; }
#pragma unroll
        for (int ai = 0; ai < 2; ++ai)
#pragma unroll
            for (int m = 0; m < 4; ++m) { const size_t off = (size_t)(u.pm * BM + ai * HALF + wr * 64 + m * 16 + fr) * 1024 + col0;
#pragma unroll
                for (int bj = 0; bj < 2; ++bj)
#pragma unroll
                    for (int n = 0; n < 2; ++n) { const f32x4 bs = *(const f32x4*)(base + off + bj * HALF + n * 16);
                        *(f32x4*)(out + off + bj * HALF + n * 16) = bs + gv[bj][n] * acc[ai][bj][m][n]; }
                if (m & 1) asm volatile("" ::: "memory"); }
    }
};
__device__ __forceinline__ float dpp_ror1(float v) { return __builtin_bit_cast(float, __builtin_amdgcn_mov_dpp(__builtin_bit_cast(int, v), 0x121, 0xf, 0xf, true)); }
__device__ __forceinline__ float dpp_ror2(float v) { return __builtin_bit_cast(float, __builtin_amdgcn_mov_dpp(__builtin_bit_cast(int, v), 0x122, 0xf, 0xf, true)); }
struct EpiConv {
    static constexpr bool PERM = true, AFTER_DRAIN = false;
    bf16_t* Gout; float* raw; const float* cw; const float* cb;
    __device__ __forceinline__ void operator()(const f32x4 (&acc)[2][2][4][2], const Unit& u, int wr, int wc, int fr, int fq) const {
        const int ch0 = u.pn * 128 + wc * 32 + 8 * fq;
#pragma unroll
        for (int n = 0; n < 2; ++n) {
            const int ch = ch0 + 4 * n;
            f32x4 w0[2], w1[2], w2[2], bb[2];
#pragma unroll
            for (int bj = 0; bj < 2; ++bj) { const int c = bj * 2816 + ch;
                w0[bj] = *(const f32x4*)(cw + c); w1[bj] = *(const f32x4*)(cw + 5632 + c); w2[bj] = *(const f32x4*)(cw + 2 * 5632 + c); bb[bj] = *(const f32x4*)(cb + c); }
#pragma unroll
            for (int ai = 0; ai < 2; ++ai)
#pragma unroll
                for (int m = 0; m < 4; ++m) {
                    const int row = u.pm * BM + ai * HALF + wr * 64 + m * 16 + fr;
                    f32x4 cv[2];
#pragma unroll
                    for (int bj = 0; bj < 2; ++bj) {
                        const f32x4 cur = acc[ai][bj][m][n]; const f32x4 prv = acc[ai][bj][m > 0 ? m - 1 : 0][n];
                        f32x4 p1, p2;
#pragma unroll
                        for (int e = 0; e < 4; ++e) { const float c1 = dpp_ror1(cur[e]), c2 = dpp_ror2(cur[e]), q1 = dpp_ror1(prv[e]), q2 = dpp_ror2(prv[e]);
                            p1[e] = fr >= 1 ? c1 : q1; p2[e] = fr >= 2 ? c2 : q2; }
                        cv[bj] = bb[bj] + w0[bj] * p2 + w1[bj] * p1 + w2[bj] * cur;
                        if (m == 0 && fr < 2) *(f32x4*)(raw + ((size_t)(row >> 6) * 4 + fr) * 5632 + bj * 2816 + ch) = cur;
                        if (m == 3 && fr >= 14) *(f32x4*)(raw + ((size_t)(row >> 6) * 4 + (fr - 12)) * 5632 + bj * 2816 + ch) = cur;
                    }
                    if (!(m == 0 && fr < 2)) {
                        f32x4 g;
#pragma unroll
                        for (int e = 0; e < 4; ++e) { const float x = cv[0][e]; g[e] = x * __builtin_amdgcn_rcpf(1.f + __builtin_amdgcn_exp2f(-1.4426950408889634f * x)) * cv[1][e]; }
                        u32x2 w; w.x = cvt_pk_bf16(g[0], g[1]); w.y = cvt_pk_bf16(g[2], g[3]);
                        *(u32x2*)(Gout + (size_t)row * 2816 + ch) = w;
                    }
                }
        }
    }
};
template <class Epi, class Sched, bool ALIGN_EPI = false, bool SP2 = false>
__device__ __forceinline__ void gemm_phase(PG8_LAS unsigned char* lds, const Gemm g, const Sched& S, const Epi& E, const int tid) {
    const int wid = __builtin_amdgcn_readfirstlane(tid >> 6), lane = tid & 63, wr = wid >> 2, wc = wid & 3, fr = lane & 15, fq = lane >> 4;
    const int K = g.K, nt = K / BK;
    unsigned voffA[2], voffB[2];
#pragma unroll
    for (int i = 0; i < 2; ++i) { int R, C; stage_rc(tid * 16 + i * 8192, R, C); const int Rb = Epi::PERM ? ((R & ~31) + perm32(R & 31)) : R;
        voffA[i] = (unsigned)(R * K + C) * 2u; voffB[i] = (unsigned)(Rb * K + C) * 2u; }
    const size_t kstep = (size_t)(BK * 2);
    const size_t hstep = (size_t)HALF * K * 2;
    const size_t tstep = 2 * hstep;
    const unsigned ldsw = (unsigned)wid * 1024u;
    const int aoff = lds_byte(wr * 64 + fr, fq * 8), boff = lds_byte(wc * 32 + fr, fq * 8);
#define PG8_SA(b, h) (((b) * 2 + (h)) * HTB)
#define PG8_SB(b, h) ((4 + (b) * 2 + (h)) * HTB)
#define PG8_STAGE(bufoff, gbase, voff) do { _Pragma("unroll") for (int _i = 0; _i < 2; ++_i) \
        __builtin_amdgcn_global_load_lds((const unsigned*)((const char*)(gbase) + (voff)[_i]), (PG8_LAS unsigned*)(lds + (bufoff) + ldsw + _i * 8192), 16, 0, 0); } while (0)
#define PG8_LDA(dst, b, h) do { _Pragma("unroll") for (int m = 0; m < 4; ++m) _Pragma("unroll") for (int k = 0; k < 2; ++k) dst[m][k] = *(const PG8_LAS bf16x8*)(lds + PG8_SA(b, h) + aoff + m * 2048 + k * 1024); } while (0)
#define PG8_LDB(dst, b, h) do { _Pragma("unroll") for (int n = 0; n < 2; ++n) _Pragma("unroll") for (int k = 0; k < 2; ++k) dst[n][k] = *(const PG8_LAS bf16x8*)(lds + PG8_SB(b, h) + boff + n * 2048 + k * 1024); } while (0)
#define PG8_MMA(ai, bj, At, Bt) do { __builtin_amdgcn_s_setprio(1); _Pragma("unroll") for (int m = 0; m < 4; ++m) _Pragma("unroll") for (int n = 0; n < 2; ++n) _Pragma("unroll") for (int k = 0; k < 2; ++k) \
        acc[ai][bj][m][n] = __builtin_amdgcn_mfma_f32_16x16x32_bf16(Bt[n][k], At[m][k], acc[ai][bj][m][n], 0, 0, 0); __builtin_amdgcn_s_setprio(0); } while (0)
#define PG8_WAIT_V(n) asm volatile("s_waitcnt vmcnt(" #n ")" ::: "memory")
#define PG8_WAIT_L(n) asm volatile("s_waitcnt lgkmcnt(" #n ")" ::: "memory")
#define PG8_BAR __builtin_amdgcn_s_barrier()
#define PG8_SCHED __builtin_amdgcn_sched_barrier(0)
    Unit cur, nxt; int ui = 0;
    if (!S.next(0, cur)) return;
    f32x4 acc[2][2][4][2];
#pragma unroll
    for (int a = 0; a < 2; ++a)
#pragma unroll
        for (int b = 0; b < 2; ++b)
#pragma unroll
            for (int m = 0; m < 4; ++m)
#pragma unroll
                for (int n = 0; n < 2; ++n) acc[a][b][m][n] = (f32x4){0.f, 0.f, 0.f, 0.f};
    bf16x8 At[4][2], B0[2][2], B1[2][2];
    const char* cA = (const char*)g.A + (size_t)cur.pm * tstep; const char* cB = (const char*)g.Bt + (size_t)cur.pn * tstep;
    S.a_ready(cur);
    if constexpr (SP2) {
        PG8_STAGE(PG8_SB(0, 0), cB, voffB); PG8_STAGE(PG8_SB(0, 1), cB + hstep, voffB); PG8_STAGE(PG8_SA(0, 0), cA, voffA); PG8_STAGE(PG8_SA(0, 1), cA + hstep, voffA);
        if (wr == 1) PG8_BAR;
        PG8_WAIT_V(2); PG8_BAR;
        PG8_STAGE(PG8_SB(1, 0), cB + kstep, voffB); PG8_STAGE(PG8_SA(1, 0), cA + kstep, voffA); PG8_STAGE(PG8_SB(1, 1), cB + hstep + kstep, voffB);
        PG8_WAIT_V(6); PG8_BAR;
    } else {
        PG8_STAGE(PG8_SB(0, 0), cB, voffB); PG8_STAGE(PG8_SA(0, 0), cA, voffA); PG8_STAGE(PG8_SB(0, 1), cB + hstep, voffB); PG8_STAGE(PG8_SA(0, 1), cA + hstep, voffA);
        if (wr == 1) PG8_BAR;
        PG8_WAIT_V(4); PG8_BAR;
        PG8_STAGE(PG8_SB(1, 0), cB + kstep, voffB); PG8_STAGE(PG8_SA(1, 0), cA + kstep, voffA); PG8_STAGE(PG8_SB(1, 1), cB + hstep + kstep, voffB);
        PG8_WAIT_V(6); PG8_BAR;
    }
    for (;;) {
        const bool has_next = S.next(ui + 1, nxt);
        const char* nA = has_next ? (const char*)g.A + (size_t)nxt.pm * tstep : cA; const char* nB = has_next ? (const char*)g.Bt + (size_t)nxt.pn * tstep : cB;
        for (int t = 0; t < nt; t += 2) {
            const bool last = (t == nt - 2);
            const char* a1 = cA + (size_t)(t + 1) * kstep;
            const char* a2 = last ? nA : cA + (size_t)(t + 2) * kstep; const char* b2 = last ? nB : cB + (size_t)(t + 2) * kstep;
            const char* a3 = a2 + kstep; const char* b3 = b2 + kstep;
            if (last && has_next) S.a_ready(nxt);
            if constexpr (SP2) {
            PG8_LDB(B0, 0, 0); PG8_LDB(B1, 0, 1); PG8_SCHED; PG8_LDA(At, 0, 0); PG8_STAGE(PG8_SA(1, 1), a1 + hstep, voffA);
            PG8_WAIT_V(8); PG8_WAIT_L(0); PG8_BAR; PG8_MMA(0, 0, At, B0); PG8_MMA(0, 1, At, B1); PG8_BAR; PG8_SCHED;
            PG8_LDA(At, 0, 1); PG8_STAGE(PG8_SB(0, 0), b2, voffB); PG8_STAGE(PG8_SB(0, 1), b2 + hstep, voffB); PG8_STAGE(PG8_SA(0, 0), a2, voffA);
            PG8_WAIT_V(8); PG8_WAIT_L(0); PG8_BAR; PG8_MMA(1, 0, At, B0); PG8_MMA(1, 1, At, B1); PG8_BAR; PG8_SCHED;
            PG8_LDB(B0, 1, 0); PG8_LDB(B1, 1, 1); PG8_SCHED; PG8_LDA(At, 1, 0); PG8_STAGE(PG8_SA(0, 1), a2 + hstep, voffA);
            PG8_WAIT_V(8); PG8_WAIT_L(0); PG8_BAR; PG8_MMA(0, 0, At, B0); PG8_MMA(0, 1, At, B1); PG8_BAR; PG8_SCHED;
            PG8_LDA(At, 1, 1); PG8_STAGE(PG8_SB(1, 0), b3, voffB); PG8_STAGE(PG8_SB(1, 1), b3 + hstep, voffB); PG8_STAGE(PG8_SA(1, 0), a3, voffA);
            PG8_WAIT_V(8); PG8_WAIT_L(0); PG8_BAR; PG8_MMA(1, 0, At, B0); PG8_MMA(1, 1, At, B1); PG8_BAR; PG8_SCHED;
            } else {
            PG8_LDB(B0, 0, 0); PG8_SCHED; PG8_LDA(At, 0, 0); PG8_STAGE(PG8_SA(1, 1), a1 + hstep, voffA);
            PG8_WAIT_L(8); PG8_BAR; PG8_WAIT_L(0); PG8_MMA(0, 0, At, B0); PG8_BAR; PG8_SCHED;
            PG8_LDB(B1, 0, 1); PG8_STAGE(PG8_SB(0, 0), b2, voffB);
            PG8_BAR; PG8_WAIT_L(0); PG8_MMA(0, 1, At, B1); PG8_BAR;
            PG8_LDA(At, 0, 1); PG8_STAGE(PG8_SA(0, 0), a2, voffA);
            PG8_BAR; PG8_WAIT_L(0); PG8_MMA(1, 0, At, B0); PG8_BAR; PG8_SCHED;
            PG8_STAGE(PG8_SB(0, 1), b2 + hstep, voffB);
            PG8_WAIT_V(6); PG8_BAR; PG8_MMA(1, 1, At, B1); PG8_BAR;
            PG8_LDB(B0, 1, 0); PG8_SCHED; PG8_LDA(At, 1, 0); PG8_STAGE(PG8_SA(0, 1), a2 + hstep, voffA);
            PG8_WAIT_L(8); PG8_BAR; PG8_WAIT_L(0); PG8_MMA(0, 0, At, B0); PG8_BAR; PG8_SCHED;
            PG8_LDB(B1, 1, 1); PG8_STAGE(PG8_SB(1, 0), b3, voffB);
            PG8_BAR; PG8_WAIT_L(0); PG8_MMA(0, 1, At, B1); PG8_BAR;
            PG8_LDA(At, 1, 1); PG8_STAGE(PG8_SA(1, 0), a3, voffA);
            PG8_BAR; PG8_WAIT_L(0); PG8_MMA(1, 0, At, B0); PG8_BAR; PG8_SCHED;
            PG8_STAGE(PG8_SB(1, 1), b3 + hstep, voffB);
            PG8_WAIT_V(6); PG8_BAR; PG8_MMA(1, 1, At, B1); PG8_BAR;
            }
        }
        if constexpr (ALIGN_EPI) { if (wr == 0) PG8_BAR; }
        if constexpr (!Epi::AFTER_DRAIN) { E(acc, cur, wr, wc, fr, fq); S.done(cur); }
        if (!has_next) break;
#pragma unroll
        for (int a = 0; a < 2; ++a)
#pragma unroll
            for (int b = 0; b < 2; ++b)
#pragma unroll
                for (int m = 0; m < 4; ++m)
#pragma unroll
                    for (int n = 0; n < 2; ++n) acc[a][b][m][n] = (f32x4){0.f, 0.f, 0.f, 0.f};
        cur = nxt; cA = nA; cB = nB; ++ui;
        if constexpr (ALIGN_EPI) { if (wr == 1) PG8_BAR; }
    }
    PG8_WAIT_V(0);
    if constexpr (!ALIGN_EPI) { if (wr == 0) PG8_BAR; }
    PG8_BAR;
    if constexpr (Epi::AFTER_DRAIN) { E.fused(acc, cur, wr, wc, fr, fq, lds, wid, lane); S.done(cur); }
#undef PG8_SA
#undef PG8_SB
#undef PG8_STAGE
#undef PG8_LDA
#undef PG8_LDB
#undef PG8_MMA
#undef PG8_WAIT_V
#undef PG8_WAIT_L
#undef PG8_BAR
#undef PG8_SCHED
}
}
#define LAS __attribute__((address_space(3)))
typedef unsigned short bf16_t;
typedef short bf16x8 __attribute__((ext_vector_type(8)));
typedef short s16x4 __attribute__((ext_vector_type(4)));
typedef float f32x4 __attribute__((ext_vector_type(4)));
typedef float f32x16 __attribute__((ext_vector_type(16)));
typedef unsigned u32x4 __attribute__((ext_vector_type(4)));
typedef unsigned u32x2 __attribute__((ext_vector_type(2)));
constexpr int NB = 8, SEQ = 2048, DM = 1024, MR = NB * SEQ, NH = 8, HD = 64, AW = 512, INC = 2056, FF = 2816, FF2 = 5632, NL = 2;
constexpr float EPS = 1e-6f, LOG2E = 1.4426950408889634f, QSCALE = 0.125f * 1.4426950408889634f;
constexpr size_t MiB = 1u << 20;
constexpr size_t WS_PART = 1 * MiB;
constexpr size_t WS_LF = 4 * MiB;
constexpr size_t WS_W0 = 5 * MiB, WS_WL = 23 * MiB;
constexpr size_t WO_IN = 0, WO_OUT = 4 * MiB, WO_UP = 6 * MiB, WO_DN = 17 * MiB, WO_PW = 22 * MiB + 512 * 1024;
constexpr size_t WS_XN = 52 * MiB;
constexpr size_t WS_Q = 84 * MiB, WS_K = 100 * MiB, WS_V = 116 * MiB, WS_U = 132 * MiB, WS_MIX = 148 * MiB;
constexpr size_t WS_G = 84 * MiB;
constexpr size_t WS_RAW = 180 * MiB;
constexpr size_t WS_END = 202 * MiB;
constexpr int LDS_BYTES = 147456;

typedef float f32x2_t __attribute__((ext_vector_type(2))); typedef __bf16 bf16x2_t __attribute__((ext_vector_type(2)));
__device__ __forceinline__ unsigned pk_bf16(float lo, float hi) { f32x2_t v = {lo, hi}; bf16x2_t b = __builtin_convertvector(v, bf16x2_t); return __builtin_bit_cast(unsigned, b); }
__device__ __forceinline__ float bf_lo(unsigned w) { return __uint_as_float(w << 16); }
__device__ __forceinline__ float bf_hi(unsigned w) { return __uint_as_float(w & 0xffff0000u); }
__device__ __forceinline__ float wave_sum(float v) {
#pragma unroll
    for (int o = 1; o < 64; o <<= 1) v += __shfl_xor(v, o);
    return v;
}

struct Args { const float* x; const float* c; const float* mod_w; const float* mod_b; const float* n1g; const float* n2g; const float* w_in; const float* b_f;
              const float* pool_w; const float* pool_scale; const float* w_out; const float* ffn_up; const float* conv_w; const float* conv_b; const float* ffn_down;
              const float* final_g; float* out; unsigned char* ws; int ph_lo, ph_hi; };

__device__ __forceinline__ void transpose_item(const float* W, int ldn, int k0, int n0src, bf16_t* WT, int K, int dst0, LAS float* scr, int lane) {
#pragma unroll 8
    for (int i = 0; i < 32; ++i) { const int kk = 2 * i + (lane >> 5); scr[kk * 33 + (lane & 31)] = W[(size_t)(k0 + kk) * ldn + n0src + (lane & 31)]; }
    asm volatile("s_waitcnt lgkmcnt(0)" ::: "memory");
    const int c = lane & 7;
#pragma unroll
    for (int j = 0; j < 4; ++j) { const int n = (lane >> 3) + 8 * j; const LAS float* s = scr + (8 * c) * 33 + n;
        u32x4 o; o.x = pk_bf16(s[0 * 33], s[1 * 33]); o.y = pk_bf16(s[2 * 33], s[3 * 33]); o.z = pk_bf16(s[4 * 33], s[5 * 33]); o.w = pk_bf16(s[6 * 33], s[7 * 33]);
        *(u32x4*)(WT + (size_t)(dst0 + n) * K + k0 + 8 * c) = o; }
    asm volatile("s_waitcnt lgkmcnt(0)" ::: "memory");
}
__device__ __forceinline__ void prologue(const Args& a, LAS unsigned char* lds, int tid, int lane, int wave, int G) {
    LAS float* cact = (LAS float*)(lds + 73728);
    for (int i = tid; i < NB * DM; i += 512) { const int b = i >> 10, k = i & 1023; const float v = a.c[i]; cact[k * 8 + b] = v / (1.f + __expf(-v)); }
    __syncthreads();
    LAS float* scr = (LAS float*)(lds + wave * 8704);
    float* part = (float*)(a.ws + WS_PART);
    const int gw = wave * G + (int)blockIdx.x, NGW = G * 8;
    constexpr int I_MOD = NL * 24 * 8, I_IN = 16 * 64, I_OUT = 16 * 32, I_UP = 16 * 176, I_DN = 44 * 32, I_PW = 4 * 2 * 4, I_L = I_IN + I_OUT + I_UP + I_DN + I_PW;
    for (int it = gw; it < I_MOD + NL * I_L; it += NGW) {
        if (it < I_MOD) {
            const int l = it / 192, r = it % 192, cc = r >> 3, kc = r & 7;
            const float* Wm = a.mod_w + (size_t)l * DM * 6144 + (size_t)(kc * 128) * 6144 + cc * 256 + lane * 4;
            f32x4 acc[8];
#pragma unroll
            for (int b = 0; b < 8; ++b) acc[b] = (f32x4){0.f, 0.f, 0.f, 0.f};
#pragma unroll 8
            for (int kk = 0; kk < 128; ++kk) { const f32x4 w = *(const f32x4*)(Wm + (size_t)kk * 6144);
                const f32x4 c0 = *(const LAS f32x4*)(cact + (kc * 128 + kk) * 8), c1 = *(const LAS f32x4*)(cact + (kc * 128 + kk) * 8 + 4);
                acc[0] += w * c0[0]; acc[1] += w * c0[1]; acc[2] += w * c0[2]; acc[3] += w * c0[3]; acc[4] += w * c1[0]; acc[5] += w * c1[1]; acc[6] += w * c1[2]; acc[7] += w * c1[3]; }
            if (kc == 0) { const f32x4 bv = *(const f32x4*)(a.mod_b + l * 6144 + cc * 256 + lane * 4);
#pragma unroll
                for (int b = 0; b < 8; ++b) acc[b] += bv; }
#pragma unroll
            for (int b = 0; b < 8; ++b) *(f32x4*)(part + ((size_t)((kc * 2 + l) * 8 + b)) * 6144 + cc * 256 + lane * 4) = acc[b];
            continue;
        }
        int r = it - I_MOD; const int l = r / I_L; r -= l * I_L;
        unsigned char* wl = a.ws + WS_W0 + (size_t)l * WS_WL;
        if (r < I_IN) { const int kb = r / 64, nb = r % 64; const int src = nb < 48 ? 32 * nb : 1544 + 32 * (nb - 48);
            transpose_item(a.w_in + (size_t)l * DM * INC, INC, 64 * kb, src, (bf16_t*)(wl + WO_IN), DM, 32 * nb, scr, lane); continue; } r -= I_IN;
        if (r < I_OUT) { const int kb = r / 32, nb = r % 32;
            transpose_item(a.w_out + (size_t)l * DM * DM, DM, 64 * kb, 32 * nb, (bf16_t*)(wl + WO_OUT), DM, 32 * nb, scr, lane); continue; } r -= I_OUT;
        if (r < I_UP) { const int kb = r / 176, nb = r % 176, pn = nb >> 3, wi = nb & 7; const int src = wi < 4 ? 128 * pn + 32 * wi : FF + 128 * pn + 32 * (wi - 4);
            transpose_item(a.ffn_up + (size_t)l * DM * FF2, FF2, 64 * kb, src, (bf16_t*)(wl + WO_UP), DM, 32 * nb, scr, lane); continue; } r -= I_UP;
        if (r < I_DN) { const int kb = r / 32, nb = r % 32;
            transpose_item(a.ffn_down + (size_t)l * FF * DM, DM, 64 * kb, 32 * nb, (bf16_t*)(wl + WO_DN), FF, 32 * nb, scr, lane); continue; } r -= I_DN;
        { const int g = r >> 3, kb = (r >> 2) & 1, nb = r & 3;
            transpose_item(a.pool_w + (size_t)(l * 4 + g) * 128 * 128, 128, 64 * kb, 32 * nb, (bf16_t*)(wl + WO_PW) + (size_t)g * 128 * 128, 128, 32 * nb, scr, lane); }
    }
}

template <bool WITH_F>
__device__ __forceinline__ void norm_phase(const Args& a, const float* xin, int l, int whichb, const float* gvec, LAS unsigned char* lds, int tid, int lane, int wave, int G) {
    LAS float* gm_l = (LAS float*)lds; LAS float* sh_l = gm_l + 1024;
    const float* part = (const float*)(a.ws + WS_PART);
    bf16_t* XN = (bf16_t*)(a.ws + WS_XN);
    float* LF = (float*)(a.ws + WS_LF);
    f32x4 wf[WITH_F ? 16 : 1][2];
    if (WITH_F) {
        const float* wi = a.w_in + (size_t)l * DM * INC + 1536;
#pragma unroll
        for (int j = 0; j < 4; ++j)
#pragma unroll
            for (int e = 0; e < 4; ++e) { const int k = 4 * lane + 256 * j + e; wf[j * 4 + e][0] = *(const f32x4*)(wi + (size_t)k * INC); wf[j * 4 + e][1] = *(const f32x4*)(wi + (size_t)k * INC + 4); }
    }
    for (int blk = blockIdx.x; blk < MR / 64; blk += G) {
        const int b = blk >> 5;
        __syncthreads();
        for (int k = tid; k < DM; k += 512) { float sh = 0.f, sc = 0.f;
#pragma unroll
            for (int kc = 0; kc < 8; ++kc) { const float* p = part + ((size_t)((kc * 2 + l) * 8 + b)) * 6144 + k; sh += p[whichb * 1024]; sc += p[(whichb + 1) * 1024]; }
            gm_l[k] = gvec[k] * (1.f + sc); sh_l[k] = sh; }
        __syncthreads();
        f32x4 gm[4], sh[4];
#pragma unroll
        for (int j = 0; j < 4; ++j) { gm[j] = *(const LAS f32x4*)(gm_l + 4 * lane + 256 * j); sh[j] = *(const LAS f32x4*)(sh_l + 4 * lane + 256 * j); }
#pragma unroll 2
        for (int i = 0; i < 8; ++i) {
            const int row = blk * 64 + wave * 8 + i;
            const f32x4* xr = (const f32x4*)(xin + (size_t)row * DM) + lane;
            f32x4 v[4]; float s = 0.f;
#pragma unroll
            for (int j = 0; j < 4; ++j) { v[j] = xr[64 * j]; s += (v[j].x * v[j].x + v[j].y * v[j].y) + (v[j].z * v[j].z + v[j].w * v[j].w); }
            const float rstd = 1.f / sqrtf(wave_sum(s) * (1.f / DM) + EPS);
            unsigned long long* o8 = (unsigned long long*)(XN + (size_t)row * DM) + lane;
#pragma unroll
            for (int j = 0; j < 4; ++j) { v[j] = v[j] * rstd * gm[j] + sh[j];
                o8[64 * j] = (unsigned long long)pk_bf16(v[j].x, v[j].y) | ((unsigned long long)pk_bf16(v[j].z, v[j].w) << 32); }
            if (WITH_F) {
                f32x4 d0 = (f32x4){0.f, 0.f, 0.f, 0.f}, d1 = d0;
#pragma unroll
                for (int j = 0; j < 4; ++j)
#pragma unroll
                    for (int e = 0; e < 4; ++e) { d0 += wf[j * 4 + e][0] * v[j][e]; d1 += wf[j * 4 + e][1] * v[j][e]; }
                float dd[8] = {d0[0], d0[1], d0[2], d0[3], d1[0], d1[1], d1[2], d1[3]};
#pragma unroll
                for (int h = 0; h < 8; ++h) dd[h] = wave_sum(dd[h]);
                float mine = dd[0];
#pragma unroll
                for (int h = 1; h < 8; ++h) mine = (lane == h) ? dd[h] : mine;
                if (lane < 8) { const float z = mine + a.b_f[l * NH + lane]; const float lf = fminf(z, 0.f) - log1pf(__expf(-fabsf(z)));
                    LF[((size_t)(b * NH + lane)) * SEQ + (row & (SEQ - 1))] = lf; }
            }
        }
    }
}

__device__ __forceinline__ void final_norm(const Args& a, int lane, int wave, int G) {
    f32x4 g[4];
#pragma unroll
    for (int j = 0; j < 4; ++j) g[j] = *((const f32x4*)a.final_g + lane + 64 * j);
    for (int row = blockIdx.x * 8 + wave; row < MR; row += G * 8) {
        f32x4* xr = (f32x4*)(a.out + (size_t)row * DM) + lane;
        f32x4 v[4]; float s = 0.f;
#pragma unroll
        for (int j = 0; j < 4; ++j) { v[j] = xr[64 * j]; s += (v[j].x * v[j].x + v[j].y * v[j].y) + (v[j].z * v[j].z + v[j].w * v[j].w); }
        const float rstd = 1.f / sqrtf(wave_sum(s) * (1.f / DM) + EPS);
#pragma unroll
        for (int j = 0; j < 4; ++j) xr[64 * j] = v[j] * rstd * g[j];
    }
}

__device__ __forceinline__ int crow(int r, int hi) { return (r & 3) + 8 * (r >> 2) + 4 * hi; }
constexpr int AL_FS = 0, AL_WT = 8192, AL_K = 16384, AL_V = 32768;
__device__ __forceinline__ void attn_unit(const Args& a, int b, int h, int qb, LAS unsigned char* lds, int tid, int lane, int wave) {
    const bf16_t* Q = (const bf16_t*)(a.ws + WS_Q); const bf16_t* K = (const bf16_t*)(a.ws + WS_K); const bf16_t* V = (const bf16_t*)(a.ws + WS_V);
    bf16_t* MIX = (bf16_t*)(a.ws + WS_MIX);
    const float* LF = (const float*)(a.ws + WS_LF) + (size_t)(b * NH + h) * SEQ;
    LAS float* FS = (LAS float*)(lds + AL_FS); LAS float* WT = (LAS float*)(lds + AL_WT);
    const int r32 = lane & 31, hi = lane >> 5;
    const int NT = 4 * (qb + 1);
    __syncthreads();
    {
        const f32x4 v = *((const f32x4*)LF + tid);
        const float tot = (v.x + v.y) + (v.z + v.w); float inc = tot;
#pragma unroll
        for (int o = 1; o < 64; o <<= 1) { const float t = __shfl_up(inc, o); if (lane >= o) inc += t; }
        if (lane == 63) WT[wave] = inc;
        __syncthreads();
        float woff = 0.f;
        for (int w = 0; w < wave; ++w) woff += WT[w];
        const float ex = woff + inc - tot;
        f32x4 o; o.x = ex + v.x; o.y = o.x + v.y; o.z = o.y + v.z; o.w = o.z + v.w;
        *(LAS f32x4*)(FS + 4 * tid) = o * LOG2E;
    }
    const int skv = tid >> 3, sc = tid & 7;
    const size_t rowb = (size_t)b * SEQ;
    const bf16_t* kg = K + (rowb + skv) * AW + h * HD + sc * 8;
    const bf16_t* vg = V + (rowb + skv) * AW + h * HD + sc * 8;
    const int kst = skv * 128 + ((sc ^ ((skv >> 1) & 7)) * 16);
    const int vst = (sc >> 2) * 4096 + (skv >> 3) * 512 + (skv & 7) * 64 + (sc & 3) * 16;
    u32x4 kreg = *(const u32x4*)(kg + (size_t)(NT - 1) * 64 * AW), vreg = *(const u32x4*)(vg + (size_t)(NT - 1) * 64 * AW);
    const int q = qb * 256 + wave * 32 + r32;
    bf16x8 qr[4];
#pragma unroll
    for (int d0 = 0; d0 < 4; ++d0) qr[d0] = *(const bf16x8*)(Q + (rowb + q) * AW + h * HD + d0 * 16 + hi * 8);
    *(LAS u32x4*)(lds + AL_K + kst) = kreg; *(LAS u32x4*)(lds + AL_V + vst) = vreg;
    __syncthreads();
    float fqm = FS[q];
    float lsum = 0.f; bool first = true;
    f32x16 o0 = {}, o1 = {};
    const int qmax = qb * 256 + wave * 32 + 31;
    int koff[4];
#pragma unroll
    for (int d0 = 0; d0 < 4; ++d0) koff[d0] = r32 * 128 + (((2 * d0 + hi) ^ ((r32 >> 1) & 7)) * 16);
    const int voff = ((lane >> 4) & 1) * 32 + (lane & 3) * 8 + (4 * hi + ((lane & 15) >> 2)) * 64;
    for (int it = 0; it < NT; ++it) {
        const int t = NT - 1 - it;
        const int cur = (it & 1) * 8192;
        if (t > 0) { kreg = *(const u32x4*)(kg + (size_t)(t - 1) * 64 * AW); vreg = *(const u32x4*)(vg + (size_t)(t - 1) * 64 * AW); }
        if (64 * t <= qmax) {
            const LAS unsigned char* Kb = lds + AL_K + cur; const LAS unsigned char* Vb = lds + AL_V + cur;
            const int kv0 = 64 * t;
            f32x16 p0, p1;
#pragma unroll
            for (int j = 0; j < 4; ++j) {
                const f32x4 f0 = *(const LAS f32x4*)(FS + kv0 + 4 * hi + 8 * j), f1 = *(const LAS f32x4*)(FS + kv0 + 32 + 4 * hi + 8 * j);
#pragma unroll
                for (int e = 0; e < 4; ++e) { p0[4 * j + e] = fqm - f0[e]; p1[4 * j + e] = fqm - f1[e]; }
            }
#pragma unroll
            for (int d0 = 0; d0 < 4; ++d0) {
                const bf16x8 k0 = *(const LAS bf16x8*)(Kb + koff[d0]); const bf16x8 k1 = *(const LAS bf16x8*)(Kb + koff[d0] + 32 * 128);
                p0 = __builtin_amdgcn_mfma_f32_32x32x16_bf16(k0, qr[d0], p0, 0, 0, 0);
                p1 = __builtin_amdgcn_mfma_f32_32x32x16_bf16(k1, qr[d0], p1, 0, 0, 0);
            }
            if (kv0 + 63 > q - r32) {
#pragma unroll
                for (int r = 0; r < 16; ++r) { const int kv = kv0 + crow(r, hi); if (kv > q) p0[r] = -INFINITY; if (kv + 32 > q) p1[r] = -INFINITY; }
            }
            float rm = fmaxf(p0[0], p1[0]);
#pragma unroll
            for (int r = 1; r < 16; ++r) rm = fmaxf(rm, fmaxf(p0[r], p1[r]));
            rm = fmaxf(rm, __shfl_xor(rm, 32));
            if (first || __any(rm > 0.f)) {
                const float dl = first ? rm : fmaxf(rm, 0.f);
                const float alpha = __builtin_amdgcn_exp2f(-dl);
                fqm -= dl; lsum *= alpha;
#pragma unroll
                for (int r = 0; r < 16; ++r) { p0[r] -= dl; p1[r] -= dl; o0[r] *= alpha; o1[r] *= alpha; }
                first = false;
            }
            float ps = 0.f;
#pragma unroll
            for (int r = 0; r < 16; ++r) { p0[r] = __builtin_amdgcn_exp2f(p0[r]); p1[r] = __builtin_amdgcn_exp2f(p1[r]); ps += p0[r] + p1[r]; }
            lsum += ps;
            u32x4 pw[4];
#pragma unroll
            for (int e = 0; e < 4; ++e) { pw[0][e] = pk_bf16(p0[2 * e], p0[2 * e + 1]); pw[1][e] = pk_bf16(p0[8 + 2 * e], p0[9 + 2 * e]);
                                          pw[2][e] = pk_bf16(p1[2 * e], p1[2 * e + 1]); pw[3][e] = pk_bf16(p1[8 + 2 * e], p1[9 + 2 * e]); }
#pragma unroll
            for (int ks = 0; ks < 4; ++ks) {
                const bf16x8 pf = __builtin_bit_cast(bf16x8, pw[ks]);
                typedef short v4i16_t __attribute__((ext_vector_type(4)));
                const s16x4 a0 = __builtin_bit_cast(s16x4, __builtin_amdgcn_ds_read_tr16_b64_v4i16((LAS v4i16_t*)(Vb + voff + ks * 1024)));
                const s16x4 a1 = __builtin_bit_cast(s16x4, __builtin_amdgcn_ds_read_tr16_b64_v4i16((LAS v4i16_t*)(Vb + voff + ks * 1024 + 512)));
                const s16x4 c0 = __builtin_bit_cast(s16x4, __builtin_amdgcn_ds_read_tr16_b64_v4i16((LAS v4i16_t*)(Vb + voff + 4096 + ks * 1024)));
                const s16x4 c1 = __builtin_bit_cast(s16x4, __builtin_amdgcn_ds_read_tr16_b64_v4i16((LAS v4i16_t*)(Vb + voff + 4096 + ks * 1024 + 512)));
                const bf16x8 v0 = (bf16x8){a0[0], a0[1], a0[2], a0[3], a1[0], a1[1], a1[2], a1[3]};
                const bf16x8 v1 = (bf16x8){c0[0], c0[1], c0[2], c0[3], c1[0], c1[1], c1[2], c1[3]};
                o0 = __builtin_amdgcn_mfma_f32_32x32x16_bf16(v0, pf, o0, 0, 0, 0);
                o1 = __builtin_amdgcn_mfma_f32_32x32x16_bf16(v1, pf, o1, 0, 0, 0);
            }
        }
        if (t > 0) { const int nxt = ((it + 1) & 1) * 8192; *(LAS u32x4*)(lds + AL_K + nxt + kst) = kreg; *(LAS u32x4*)(lds + AL_V + nxt + vst) = vreg; }
        __syncthreads();
    }
    lsum += __shfl_xor(lsum, 32);
    const float inv = 1.f / lsum;
    bf16_t* orow = MIX + (rowb + q) * DM + h * HD + 4 * hi;
#pragma unroll
    for (int j = 0; j < 4; ++j) {
        u32x2 w0, w1;
        w0.x = pk_bf16(o0[4 * j] * inv, o0[4 * j + 1] * inv); w0.y = pk_bf16(o0[4 * j + 2] * inv, o0[4 * j + 3] * inv);
        w1.x = pk_bf16(o1[4 * j] * inv, o1[4 * j + 1] * inv); w1.y = pk_bf16(o1[4 * j + 2] * inv, o1[4 * j + 3] * inv);
        *(u32x2*)(orow + 8 * j) = w0; *(u32x2*)(orow + 32 + 8 * j) = w1;
    }
}

constexpr int PL_PITCH = 272;
template <int GI>
__device__ __forceinline__ void pool_item(const Args& a, int l, int rb, LAS unsigned char* lds, int tid, int lane, int wave) {
    constexpr int W = 2 << GI;
    const bf16_t* U = (const bf16_t*)(a.ws + WS_U); bf16_t* MIX = (bf16_t*)(a.ws + WS_MIX);
    const bf16_t* PW = (const bf16_t*)(a.ws + WS_W0 + (size_t)l * WS_WL + WO_PW) + (size_t)GI * 128 * 128;
    int ln = lane; asm volatile("" : "+v"(ln));
    const int fr = ln & 15, fq = ln >> 4;
    const int row0 = rb * 128; const bool seq0 = (row0 & (SEQ - 1)) == 0;
    __syncthreads();
    for (int i = tid; i < 143 * 16; i += 512) { const int r = i >> 4, c = i & 15;
        u32x4 v = (u32x4){0u, 0u, 0u, 0u};
        if (!(seq0 && r < 15)) v = *(const u32x4*)(U + (size_t)(row0 - 15 + r) * AW + 128 * GI + 8 * c);
        *(LAS u32x4*)(lds + r * PL_PITCH + c * 16) = v; }
    const bf16_t* PWl = PW + (size_t)fr * 128 + 8 * fq;
    bf16x8 bw[4][4];
#pragma unroll
    for (int n2 = 0; n2 < 4; ++n2)
#pragma unroll
        for (int ks = 0; ks < 4; ++ks) bw[n2][ks] = *(const bf16x8*)(PWl + (size_t)(16 * n2) * 128 + 32 * ks);
    f32x4 psv[8];
#pragma unroll
    for (int nt = 0; nt < 8; ++nt) psv[nt] = *(const f32x4*)(a.pool_scale + l * 512 + 128 * GI + 16 * nt + 4 * fq);
    __syncthreads();
    const int row = row0 + wave * 16 + fr, t = row & (SEQ - 1);
    const int cnt = (t + 1) < W ? (t + 1) : W; const float rc = 1.f / (float)cnt;
    const LAS unsigned char* lp = lds + (15 + wave * 16 + fr) * PL_PITCH + fq * 16;
    bf16x8 af[4];
#pragma unroll
    for (int ks = 0; ks < 4; ++ks) {
        const u32x4 self = *(const LAS u32x4*)(lp + ks * 64);
        float sm[8];
#pragma unroll
        for (int e = 0; e < 4; ++e) { sm[2 * e] = bf_lo(self[e]); sm[2 * e + 1] = bf_hi(self[e]); }
#pragma unroll
        for (int j = 1; j < W; ++j) { const u32x4 v = *(const LAS u32x4*)(lp + ks * 64 - j * PL_PITCH);
#pragma unroll
            for (int e = 0; e < 4; ++e) { sm[2 * e] += bf_lo(v[e]); sm[2 * e + 1] += bf_hi(v[e]); } }
        u32x4 pk;
#pragma unroll
        for (int e = 0; e < 4; ++e) pk[e] = pk_bf16(sm[2 * e] * rc - bf_lo(self[e]), sm[2 * e + 1] * rc - bf_hi(self[e]));
        af[ks] = __builtin_bit_cast(bf16x8, pk);
    }
#pragma unroll
    for (int nt = 0; nt < 8; ++nt) {
        if (nt == 4) {
#pragma unroll
            for (int n2 = 0; n2 < 4; ++n2)
#pragma unroll
                for (int ks = 0; ks < 4; ++ks) bw[n2][ks] = *(const bf16x8*)(PWl + (size_t)(16 * (4 + n2)) * 128 + 32 * ks);
        }
        f32x4 acc = (f32x4){0.f, 0.f, 0.f, 0.f};
#pragma unroll
        for (int ks = 0; ks < 4; ++ks) acc = __builtin_amdgcn_mfma_f32_16x16x32_bf16(bw[nt & 3][ks], af[ks], acc, 0, 0, 0);
        const int n0 = 128 * GI + 16 * nt + 4 * fq;
        const f32x4 ps = psv[nt];
        u32x2 o; o.x = pk_bf16(acc[0] * ps[0], acc[1] * ps[1]); o.y = pk_bf16(acc[2] * ps[2], acc[3] * ps[3]);
        *(u32x2*)(MIX + (size_t)row * DM + 512 + n0) = o;
    }
    asm volatile("" ::: "memory");
}

__device__ __forceinline__ void conv_fixup(const Args& a, int l, int pm, int tid) {
    const float* raw = (const float*)(a.ws + WS_RAW); bf16_t* Gb = (bf16_t*)(a.ws + WS_G);
    const float* cw = a.conv_w + (size_t)l * 3 * FF2; const float* cb = a.conv_b + (size_t)l * FF2;
    for (int i = tid; i < 4 * 2 * (FF / 4); i += 512) {
        const int c4 = i % (FF / 4), rr = (i / (FF / 4)) & 1, rg = i / (2 * (FF / 4));
        const int range = pm * 4 + rg, row = range * 64 + rr, ch = 4 * c4;
        const bool first = ((range * 64) & (SEQ - 1)) == 0;
        f32x4 cv[2];
#pragma unroll
        for (int bj = 0; bj < 2; ++bj) {
            const int c = bj * FF + ch;
            const f32x4 cur = *(const f32x4*)(raw + ((size_t)range * 4 + rr) * FF2 + c);
            f32x4 p1, p2; const f32x4 z = (f32x4){0.f, 0.f, 0.f, 0.f};
            if (rr == 0) { p1 = first ? z : *(const f32x4*)(raw + ((size_t)(range - 1) * 4 + 3) * FF2 + c); p2 = first ? z : *(const f32x4*)(raw + ((size_t)(range - 1) * 4 + 2) * FF2 + c); }
            else { p1 = *(const f32x4*)(raw + ((size_t)range * 4 + 0) * FF2 + c); p2 = first ? z : *(const f32x4*)(raw + ((size_t)(range - 1) * 4 + 3) * FF2 + c); }
            cv[bj] = *(const f32x4*)(cb + c) + *(const f32x4*)(cw + c) * p2 + *(const f32x4*)(cw + FF2 + c) * p1 + *(const f32x4*)(cw + 2 * FF2 + c) * cur;
        }
        f32x4 gg;
#pragma unroll
        for (int e = 0; e < 4; ++e) { const float x = cv[0][e]; gg[e] = x * __builtin_amdgcn_rcpf(1.f + __builtin_amdgcn_exp2f(-LOG2E * x)) * cv[1][e]; }
        u32x2 w; w.x = pk_bf16(gg[0], gg[1]); w.y = pk_bf16(gg[2], gg[3]);
        *(u32x2*)(Gb + (size_t)row * FF + ch) = w;
    }
}

#define XB_TMO      128
#define XB_XCNT(j)  (256  + 64 * (j))
#define XB_XSUB(j)  (1280 + 64 * (j))
#define XB_XGEN(j)  (2304 + 64 * (j))
#define XB_TOP      3328
#define XB_TOPGEN   3392
#define XCD_BAR_WORDS 3456
#define XB_SPIN_CAP (1u << 18)

__device__ __forceinline__ unsigned xb_ld(unsigned* p)              { return __hip_atomic_load(p, __ATOMIC_RELAXED, __HIP_MEMORY_SCOPE_AGENT); }
__device__ __forceinline__ unsigned xb_add(unsigned* p, unsigned v) { return __hip_atomic_fetch_add(p, v, __ATOMIC_RELAXED, __HIP_MEMORY_SCOPE_AGENT); }
__device__ __forceinline__ unsigned xb_xcc_id() { return (unsigned)__builtin_amdgcn_s_getreg((3 << 11) | 20) & 0xFu; }
#define XB_SPIN(cond, bar) do { unsigned _sp = 0; while (cond) { __builtin_amdgcn_s_sleep(1); \
    if ((++_sp & 255u) == 0u) { if (xb_ld(&(bar)[XB_TMO])) break; if (_sp > XB_SPIN_CAP) { atomicAdd(&(bar)[XB_TMO], 1u); break; } } } } while (0)

struct XcdBarrier {
    unsigned* bar; unsigned x;
    volatile LAS unsigned* st;
};

__device__ __forceinline__ XcdBarrier xcd_barrier_post(unsigned* bar, volatile LAS unsigned* st) {
    XcdBarrier b; b.bar = bar; b.x = xb_xcc_id(); b.st = st;
    if (threadIdx.x == 0) (void)xb_add(&bar[XB_XCNT(b.x)], 1u);
    return b;
}
__device__ __forceinline__ void xcd_barrier_complete(unsigned* bar, unsigned x, unsigned& nloc, unsigned& nx) {
    const unsigned G = gridDim.x * gridDim.y * gridDim.z;
    unsigned sum, cnt, mine, sp = 0u;
    for (;;) {
        sum = 0u; cnt = 0u; mine = 0u;
#pragma unroll
        for (unsigned j = 0; j < 16; ++j) { const unsigned c = xb_ld(&bar[XB_XCNT(j)]); sum += c; cnt += (c > 0u) ? 1u : 0u; mine = (j == x) ? c : mine; }
        if (sum == G) break;
        __builtin_amdgcn_s_sleep(1);
        if ((++sp & 255u) == 0u) { if (xb_ld(&bar[XB_TMO])) break; if (sp > XB_SPIN_CAP) { atomicAdd(&bar[XB_TMO], 1u); break; } }
    }
    nloc = mine > 0u ? mine : 1u; nx = cnt > 0u ? cnt : 1u;
}

__device__ __forceinline__ void xcd_barrier(const XcdBarrier& b) {
    asm volatile("s_waitcnt vmcnt(0)" ::: "memory");
    __syncthreads();
    if (threadIdx.x == 0) {
        unsigned* bar = b.bar;
        __builtin_amdgcn_s_waitcnt(0);
        unsigned nloc = b.st[0], nx = b.st[1];
        if (nloc == 0u) { xcd_barrier_complete(bar, b.x, nloc, nx); b.st[0] = nloc; b.st[1] = nx; }
        const unsigned old = xb_add(&bar[XB_XSUB(b.x)], 1u);
        const unsigned gen = old / nloc;
        if (old + 1u == (gen + 1u) * nloc) {
            __builtin_amdgcn_fence(__ATOMIC_RELEASE, "agent");
            asm volatile("s_waitcnt vmcnt(0)" ::: "memory");
            const unsigned og = xb_add(&bar[XB_TOP], 1u);
            const unsigned tg = og / nx;
            if (og + 1u == (tg + 1u) * nx) xb_add(&bar[XB_TOPGEN], 1u);
            else XB_SPIN(xb_ld(&bar[XB_TOPGEN]) == tg, bar);
            __builtin_amdgcn_fence(__ATOMIC_ACQUIRE, "agent");
            xb_add(&bar[XB_XGEN(b.x)], 1u);
            asm volatile("s_waitcnt vmcnt(0)" ::: "memory");
        } else {
            XB_SPIN(xb_ld(&bar[XB_XGEN(b.x)]) == gen, bar);
            __builtin_amdgcn_fence(__ATOMIC_ACQUIRE, "agent");
            asm volatile("s_waitcnt vmcnt(0)" ::: "memory");
        }
    }
    __syncthreads();
}

__global__ void __launch_bounds__(512, 2) fwd_kernel(Args a) {
    extern __shared__ __attribute__((aligned(16))) unsigned char lds_raw[];
    LAS unsigned char* lds = (LAS unsigned char*)lds_raw;
    cg::grid_group grid = cg::this_grid();
    { volatile LAS unsigned* st0 = (volatile LAS unsigned*)(lds + LDS_BYTES - 64); if (threadIdx.x < 2) st0[threadIdx.x] = 0u; __syncthreads(); }
    XcdBarrier bar = xcd_barrier_post((unsigned*)a.ws, (volatile LAS unsigned*)(lds + LDS_BYTES - 64));
    const int tid0 = threadIdx.x, G = gridDim.x;
    const int lo = a.ph_lo, hi = a.ph_hi;
    if (hi < 0) grid.sync();
    int ph = 0;
#define SEAM() do { if (lo <= ph && ph + 1 < hi) { xcd_barrier(bar); if ((DUP_MASK >> 10) & 1) xcd_barrier(bar); } ++ph; } while (0)
#define RUN() (lo <= ph && ph < hi)
#ifndef PH_MASK
#define PH_MASK 0x3ff
#endif
#define PHM(k) ((PH_MASK >> (k)) & 1)
#ifndef DUP_MASK
#define DUP_MASK 0
#endif
#define DUP(k) for (int rep_ = 0; rep_ < (((DUP_MASK >> (k)) & 1) ? 2 : 1); ++rep_)
#define FRESH() int tid = tid0, l = l0; asm volatile("" : "+v"(tid), "+s"(l)); const int lane = tid & 63, wave = __builtin_amdgcn_readfirstlane(tid >> 6); (void)lane; (void)wave;
    if (PHM(0) && RUN()) DUP(0) { const int l0 = 0; FRESH(); prologue(a, lds, tid, lane, wave, G); }
    SEAM();
    for (int l0 = 0; l0 < NL; ++l0) {
        if (PHM(1) && RUN()) DUP(1) { FRESH(); const float* xres = (l == 0) ? a.x : a.out; norm_phase<true>(a, xres, l, 0, a.n1g + l * DM, lds, tid, lane, wave, G); }
        SEAM();
        if (PHM(2) && RUN()) DUP(2) { FRESH(); unsigned char* wl = a.ws + WS_W0 + (size_t)l * WS_WL; pg8::Gemm g{(const bf16_t*)(a.ws + WS_XN), (const bf16_t*)(wl + WO_IN), MR, 2048, DM}; pg8::StaticOrder S; S.init(MR, 2048, G, (int)blockIdx.x);
            pg8::EpiBf16 E{(bf16_t*)(a.ws + WS_Q), AW, AW, (size_t)MR * AW, QSCALE};
            pg8::gemm_phase<pg8::EpiBf16, pg8::StaticOrder, true, true>(lds, g, S, E, tid); }
        SEAM();
        if (RUN()) { FRESH();
            if (PHM(3)) DUP(3) for (int p = blockIdx.x; p < NB * NH * 4; p += G) { const int bh = p >> 2, s = p & 3;
                attn_unit(a, bh >> 3, bh & 7, 7 - s, lds, tid, lane, wave);
                attn_unit(a, bh >> 3, bh & 7, s, lds, tid, lane, wave); }
            if (PHM(4)) DUP(4) for (int p = blockIdx.x; p < (MR / 128) * 2; p += G) {
                const int rb = p >> 1;
                if (p & 1) { pool_item<1>(a, l, rb, lds, tid, lane, wave); pool_item<2>(a, l, rb, lds, tid, lane, wave); } else { pool_item<0>(a, l, rb, lds, tid, lane, wave); pool_item<3>(a, l, rb, lds, tid, lane, wave); } }
        }
        SEAM();
        if (PHM(5) && RUN()) for (int rep_ = 0; rep_ < ((((DUP_MASK >> 5) & 1) && l0 == 0) ? 2 : 1); ++rep_) { FRESH(); unsigned char* wl = a.ws + WS_W0 + (size_t)l * WS_WL; const float* xres = (l == 0) ? a.x : a.out; pg8::Gemm g{(const bf16_t*)(a.ws + WS_MIX), (const bf16_t*)(wl + WO_OUT), MR, DM, DM}; pg8::StaticOrder S; S.init(MR, DM, G, (int)blockIdx.x);
            pg8::EpiRes E{xres, a.out, (const float*)(a.ws + WS_PART), l, 2, 1.f};
            pg8::gemm_phase<pg8::EpiRes, pg8::StaticOrder, true, true>(lds, g, S, E, tid); }
        SEAM();
        if (PHM(6) && RUN()) DUP(6) { FRESH(); norm_phase<false>(a, a.out, l, 3, a.n2g + l * DM, lds, tid, lane, wave, G); }
        SEAM();
        if (PHM(7) && RUN()) DUP(7) { FRESH(); unsigned char* wl = a.ws + WS_W0 + (size_t)l * WS_WL; pg8::Gemm g{(const bf16_t*)(a.ws + WS_XN), (const bf16_t*)(wl + WO_UP), MR, FF2, DM}; pg8::StaticOrder S; S.init(MR, FF2, G, (int)blockIdx.x);
            pg8::EpiConv E{(bf16_t*)(a.ws + WS_G), (float*)(a.ws + WS_RAW), a.conv_w + (size_t)l * 3 * FF2, a.conv_b + (size_t)l * FF2};
            pg8::gemm_phase<pg8::EpiConv, pg8::StaticOrder, true, true>(lds, g, S, E, tid); }
        SEAM();
        if (PHM(8) && RUN()) for (int rep_ = (((DUP_MASK >> 8) & 1) ? 0 : 1); rep_ < 2; ++rep_) { FRESH(); unsigned char* wl = a.ws + WS_W0 + (size_t)l * WS_WL; pg8::Gemm g{(const bf16_t*)(a.ws + WS_G), (const bf16_t*)(wl + WO_DN), MR, DM, FF}; pg8::StaticOrder S; S.init(MR, DM, G, (int)blockIdx.x);
            pg8::Unit u; for (int i = 0; S.next(i, u); ++i) conv_fixup(a, l, u.pm, tid);
            asm volatile("s_waitcnt vmcnt(0)" ::: "memory"); __builtin_amdgcn_fence(__ATOMIC_ACQUIRE, "agent"); asm volatile("s_waitcnt vmcnt(0)" ::: "memory"); __syncthreads();
            pg8::EpiRes E{a.out, a.out, (const float*)(a.ws + WS_PART), l, 5, rep_ == 0 ? 0.f : 1.f};
            pg8::gemm_phase<pg8::EpiRes, pg8::StaticOrder, true, true>(lds, g, S, E, tid); }
        SEAM();
    }
    if (PHM(9) && RUN()) { const int l0 = 0; FRESH(); final_norm(a, lane, wave, G); }
#undef SEAM
#undef RUN
}

#ifndef N_LAUNCH_MODE
#define N_LAUNCH_MODE 1
#endif
extern "C" void kernel_launch(void* const* d_in, const int* in_sizes, int n_in, void* d_out, int out_size, void* d_ws, size_t ws_size, hipStream_t stream) {
    static int grid = 0;
    if (grid == 0) {
        if (n_in != 16 || out_size != MR * DM || ws_size < WS_END) { fprintf(stderr, "kernel_launch: unexpected shapes (n_in %d out %d ws %zu)\n", n_in, out_size, ws_size); grid = -1; return; }
        int dev = 0, cus = 0, per_cu = 0;
        hipGetDevice(&dev); hipDeviceGetAttribute(&cus, hipDeviceAttributeMultiprocessorCount, dev);
        if (hipFuncSetAttribute((const void*)fwd_kernel, hipFuncAttributeMaxDynamicSharedMemorySize, LDS_BYTES) != hipSuccess) { fprintf(stderr, "kernel_launch: hipFuncSetAttribute failed\n"); grid = -1; return; }
        if (hipOccupancyMaxActiveBlocksPerMultiprocessor(&per_cu, (const void*)fwd_kernel, 512, LDS_BYTES) != hipSuccess || per_cu < 1) { fprintf(stderr, "kernel_launch: occupancy query says %d\n", per_cu); (void)hipGetLastError(); per_cu = 1; }
        grid = cus * 1;
        if (grid > cus * per_cu) grid = cus * per_cu;
    }
    if (grid < 0) return;
    if (hipMemsetAsync(d_ws, 0, 16384, stream) != hipSuccess) { fprintf(stderr, "kernel_launch: memset failed\n"); return; }
    Args a{};
    a.x = (const float*)d_in[0]; a.c = (const float*)d_in[1]; a.mod_w = (const float*)d_in[2]; a.mod_b = (const float*)d_in[3]; a.n1g = (const float*)d_in[4]; a.n2g = (const float*)d_in[5];
    a.w_in = (const float*)d_in[6]; a.b_f = (const float*)d_in[7]; a.pool_w = (const float*)d_in[8]; a.pool_scale = (const float*)d_in[9]; a.w_out = (const float*)d_in[10];
    a.ffn_up = (const float*)d_in[11]; a.conv_w = (const float*)d_in[12]; a.conv_b = (const float*)d_in[13]; a.ffn_down = (const float*)d_in[14]; a.final_g = (const float*)d_in[15];
    a.out = (float*)d_out; a.ws = (unsigned char*)d_ws;
    constexpr int NPH = 1 + 7 * NL + 1;
#if N_LAUNCH_MODE == 1
    a.ph_lo = 0; a.ph_hi = NPH;
    void* args[] = {&a};
    hipError_t e = hipLaunchCooperativeKernel((const void*)fwd_kernel, dim3(grid), dim3(512), args, LDS_BYTES, stream);
    if (e != hipSuccess) fprintf(stderr, "cooperative launch failed: %s (grid %d)\n", hipGetErrorString(e), grid);
#else
    for (int p = 0; p < NPH; ++p) { a.ph_lo = p; a.ph_hi = p + 1; hipLaunchKernelGGL(fwd_kernel, dim3(grid), dim3(512), LDS_BYTES, stream, a); }
#endif
}
```
